# Optimizing an MI355X kernel written in HIP

```python
import jax, jax.numpy as jnp
from jax import lax
import numpy as np

D_MODEL = 1024
BATCH = 16
SEQ = 2048
DEPTH = 2

N_MIXERS = 2
N_A_LAYERS = (DEPTH + 1) // 2
N_B_LAYERS = DEPTH // 2
D_FF = ((8 * D_MODEL // 3 + 127) // 128) * 128
CHUNK = 128
A_DIM = 2 * D_MODEL
A_HEADS = 8
A_HEAD_DIM = A_DIM // A_HEADS
POOL_WINDOWS = (2, 4, 8, 16)
B_GROUPS = len(POOL_WINDOWS)
B_DIM = D_MODEL
B_GROUP_DIM = B_DIM // B_GROUPS
EPS = 1e-6

kernel_name = "hybrid_sgu_pool_macaron"


def rmsnorm(x, g):
    xf = x.astype(jnp.float32)
    y = xf * lax.rsqrt(jnp.mean(xf * xf, axis=-1, keepdims=True) + EPS)
    return (y * g.astype(jnp.float32)).astype(x.dtype)


def swiglu(h, w_in, w_out):
    gate, up = jnp.split(h @ w_in, 2, axis=-1)
    return (jax.nn.silu(gate) * up) @ w_out


def chunked_sgu(h, w_in, v_norm, w_s, b_s, w_out):
    bsz, seq, _ = h.shape
    z = jax.nn.gelu(h @ w_in)
    u, v = jnp.split(z, 2, axis=-1)
    v = rmsnorm(v, v_norm)
    v = v.reshape(bsz, seq // CHUNK, CHUNK, A_HEADS, A_HEAD_DIM)
    causal = jnp.tril(jnp.ones((CHUNK, CHUNK), dtype=bool))
    ws = jnp.where(causal[None], w_s, jnp.zeros_like(w_s))
    gate = jnp.einsum('hts,bcshd->bcthd', ws, v) + b_s.T[None, None, :, :, None]
    gate = gate.reshape(bsz, seq, A_DIM)
    return (u * gate) @ w_out


def causal_mean(x, window):
    seq = x.shape[1]
    c = jnp.cumsum(x.astype(jnp.float32), axis=1)
    c_prev = jnp.pad(c, ((0, 0), (window, 0), (0, 0)))[:, :seq]
    cnt = jnp.minimum(jnp.arange(1, seq + 1), window).astype(jnp.float32)[None, :, None]
    return ((c - c_prev) / cnt).astype(x.dtype)


def pool_mixer(h, w_in, w_grp, scale, w_out):
    bsz, seq, _ = h.shape
    p = h @ w_in
    groups = jnp.split(p, B_GROUPS, axis=-1)
    pooled = jnp.stack([causal_mean(g, w) - g for g, w in zip(groups, POOL_WINDOWS)], axis=2)
    y = jnp.einsum('bsgc,gcd->bsgd', pooled, w_grp).reshape(bsz, seq, B_DIM)
    return (y * scale) @ w_out


def setup_inputs(seed: int = 0) -> dict:
    key = jax.random.key(seed)
    ks = jax.random.split(key, 16)
    f32 = jnp.float32
    nrm = lambda k, shape, fan_in: jax.random.normal(k, shape, f32) * (fan_in ** -0.5)
    gain = lambda k, shape: 1.0 + 0.02 * jax.random.normal(k, shape, f32)
    return {
        "x": jax.random.normal(ks[0], (BATCH, SEQ, D_MODEL), f32),
        "ffn_norm": gain(ks[1], (DEPTH, 2, D_MODEL)),
        "ffn_w_in": nrm(ks[2], (DEPTH, 2, D_MODEL, 2 * D_FF), D_MODEL),
        "ffn_w_out": nrm(ks[3], (DEPTH, 2, D_FF, D_MODEL), D_FF),
        "mix_norm": gain(ks[4], (DEPTH, D_MODEL)),
        "a_w_in": nrm(ks[5], (N_A_LAYERS, D_MODEL, 2 * A_DIM), D_MODEL),
        "a_v_norm": gain(ks[6], (N_A_LAYERS, A_DIM)),
        "a_w_s": nrm(ks[7], (N_A_LAYERS, A_HEADS, CHUNK, CHUNK), CHUNK),
        "a_b_s": 1.0 + 0.02 * jax.random.normal(ks[8], (N_A_LAYERS, A_HEADS, CHUNK), f32),
        "a_w_out": nrm(ks[9], (N_A_LAYERS, A_DIM, D_MODEL), A_DIM),
        "b_w_in": nrm(ks[10], (N_B_LAYERS, D_MODEL, B_DIM), D_MODEL),
        "b_w_grp": nrm(ks[11], (N_B_LAYERS, B_GROUPS, B_GROUP_DIM, B_GROUP_DIM), B_GROUP_DIM),
        "b_scale": gain(ks[12], (N_B_LAYERS, B_DIM)),
        "b_w_out": nrm(ks[13], (N_B_LAYERS, B_DIM, D_MODEL), B_DIM),
        "final_norm": gain(ks[14], (D_MODEL,)),
    }


def reference(x, ffn_norm, ffn_w_in, ffn_w_out, mix_norm, a_w_in, a_v_norm, a_w_s, a_b_s,
              a_w_out, b_w_in, b_w_grp, b_scale, b_w_out, final_norm):
    for i in range(DEPTH):
        x = x + 0.5 * swiglu(rmsnorm(x, ffn_norm[i, 0]), ffn_w_in[i, 0], ffn_w_out[i, 0])
        h = rmsnorm(x, mix_norm[i])
        j = i // N_MIXERS
        if i % N_MIXERS == 0:
            x = x + chunked_sgu(h, a_w_in[j], a_v_norm[j], a_w_s[j], a_b_s[j], a_w_out[j])
        else:
            x = x + pool_mixer(h, b_w_in[j], b_w_grp[j], b_scale[j], b_w_out[j])
        x = x + 0.5 * swiglu(rmsnorm(x, ffn_norm[i, 1]), ffn_w_in[i, 1], ffn_w_out[i, 1])
    return rmsnorm(x, final_norm)
```

```cpp
#include <hip/hip_runtime.h>
#include <hip/hip_cooperative_groups.h>
#include <cstdio>
#include <cstdint>
namespace cg = cooperative_groups;
namespace pg8 {
#define PG8_LAS __attribute__((address_space(3)))
typedef unsigned short bf16_t;
typedef short bf16x8 __attribute__((ext_vector_type(8)));
typedef float f32x4 __attribute__((ext_vector_type(4)));
typedef unsigned u32x4 __attribute__((ext_vector_type(4)));
constexpr int BM = 256, BK = 64, HALF = 128, HTB = HALF * BK * 2  , STAGE_BYTES = 8 * HTB, NXCD = 8, WGM = 8;

__host__ __device__ __forceinline__ int lds_byte(int r, int c) { const int st = (r >> 4) * 2 + (c >> 5), rr = r & 15, cc = c & 31, ob = rr * 64 + cc * 2; return st * 1024 + (ob ^ (((ob >> 9) & 1) << 5)); }
__host__ __device__ __forceinline__ void stage_rc(int b, int& R, int& C) { const int st = b / 1024, sb = b % 1024, swz = sb ^ (((sb >> 9) & 1) << 5); R = (st >> 1) * 16 + swz / 64; C = (st & 1) * 32 + (swz % 64) / 2; }
__host__ __device__ __forceinline__ int perm32(int rho) { const int n = rho >> 4, i = rho & 15; return 8 * (i >> 2) + 4 * n + (i & 3); }

struct Unit { int pm, pn; };
struct Gemm { const bf16_t* A; const bf16_t* Bt; int M, N, K; };

struct StaticOrder {
    int nM, nN, nwg, G, c;
    __host__ __device__ void init(int M, int N, int G_, int c_) { nM = M / BM; nN = N / BM; nwg = nM * nN; G = G_; c = c_; }
    __host__ __device__ bool next(int i, Unit& u) const {
        const long L = (long)i * G + c; if (L >= nwg) return false;
        int wgid = (int)L; { const int q = nwg / NXCD, r = nwg % NXCD, xcd = wgid % NXCD, off = wgid / NXCD; wgid = (xcd < r ? xcd * (q + 1) : r * (q + 1) + (xcd - r) * q) + off; }
        const int nig = WGM * nN, gid = wgid / nig, fm = gid * WGM, gsz = (nM - fm) < WGM ? (nM - fm) : WGM;
        u.pm = fm + ((wgid % nig) % gsz); u.pn = (wgid % nig) / gsz; return true;
    }
    __device__ __forceinline__ void a_ready(const Unit&) const {}
    __device__ __forceinline__ void done(const Unit&) const {}
};

__device__ __forceinline__ unsigned cvt_pk_bf16(float lo, float hi) { unsigned r; asm volatile("v_cvt_pk_bf16_f32 %0, %1, %2" : "=v"(r) : "v"(lo), "v"(hi)); return r; }
constexpr float EPS = 1e-6f;
typedef float f32x2 __attribute__((ext_vector_type(2)));
__device__ __forceinline__ float rstd_row(const float* ssq4, int row, float inv_n) {
    const f32x4 p = *(const f32x4*)(ssq4 + (size_t)row * 4);
    return __builtin_amdgcn_rsqf(((p[0] + p[1]) + (p[2] + p[3])) * inv_n + EPS);
}
__device__ __forceinline__ float rstd_lds(const PG8_LAS float* R4, int lrow, float inv_n) {
    const f32x4 p = *(const PG8_LAS f32x4*)(R4 + lrow * 4);
    return __builtin_amdgcn_rsqf(((p[0] + p[1]) + (p[2] + p[3])) * inv_n + EPS);
}
__device__ __forceinline__ void rows_prefetch(const float* ssq4, PG8_LAS float* R4, const Unit& u, int wid, int lane) {
    if (wid < 4) __builtin_amdgcn_global_load_lds((const unsigned*)(ssq4 + (size_t)(u.pm * BM + wid * 64 + lane) * 4), (PG8_LAS unsigned*)(R4 + wid * 256), 16, 0, 0);
}
__device__ __forceinline__ float silu_f(float g) { return g * __builtin_amdgcn_rcpf(1.0f + __builtin_amdgcn_exp2f(g * -1.4426950408889634f)); }
__device__ __forceinline__ float gelu_f(float x) { const float t = x * (1.0f + 0.044715f * x * x); return x * __builtin_amdgcn_rcpf(1.0f + __builtin_amdgcn_exp2f(t * -2.3022082090378f)); }

struct EpiSwiGLU {
    static constexpr bool PERM = true, AFTER_DRAIN = false;
    bf16_t* H; int ldh; const float* ssq; PG8_LAS float* R4;
    __device__ __forceinline__ void prefetch(const Unit& u, int wid, int lane) const { rows_prefetch(ssq, R4, u, wid, lane); }
    __device__ __forceinline__ void operator()(const f32x4 (&acc)[2][2][4][2], const Unit& u, int wr, int wc, int fr, int fq) const {
        const int row0 = u.pm * BM + wr * 64 + fr, col0 = u.pn * HALF + wc * 32 + 8 * fq;
#pragma unroll
        for (int ai = 0; ai < 2; ++ai)
#pragma unroll
            for (int m = 0; m < 4; ++m) {
                const int r = row0 + ai * HALF + m * 16; const float rs = rstd_lds(R4, ai * HALF + wr * 64 + m * 16 + fr, 1.0f / 1024.0f);
                u32x4 w; const float cexp = rs * -1.4426950408889634f, rs2 = rs * rs;
#pragma unroll
                for (int n = 0; n < 2; ++n)
#pragma unroll
                    for (int h = 0; h < 2; ++h) { const f32x2 g = (f32x2){acc[ai][0][m][n][2 * h], acc[ai][0][m][n][2 * h + 1]}, up = (f32x2){acc[ai][1][m][n][2 * h], acc[ai][1][m][n][2 * h + 1]};
                        const f32x2 p = (g * up) * rs2, t = g * cexp; f32x2 e; e.x = __builtin_amdgcn_exp2f(t.x); e.y = __builtin_amdgcn_exp2f(t.y);
                        const f32x2 d = e + 1.0f; f32x2 rc; rc.x = __builtin_amdgcn_rcpf(d.x); rc.y = __builtin_amdgcn_rcpf(d.y); const f32x2 o = p * rc;
                        w[2 * n + h] = cvt_pk_bf16(o.x, o.y); }
                *(u32x4*)(H + (size_t)r * ldh + col0) = w;
            }
    }
};
template <int ACT> struct EpiAct {
    static constexpr bool PERM = true, AFTER_DRAIN = false;
    bf16_t* O0; bf16_t* O1; int ldc; int split; const float* ssq; float* ssqv; PG8_LAS float* P; PG8_LAS float* R4;
    __device__ __forceinline__ void prefetch(const Unit& u, int wid, int lane) const { rows_prefetch(ssq, R4, u, wid, lane); }
    __device__ __forceinline__ void operator()(const f32x4 (&acc)[2][2][4][2], const Unit& u, int wr, int wc, int fr, int fq) const {
        const int row0 = u.pm * BM + wr * 64 + fr; bf16_t* base = O0; int colt = u.pn * BM; bool isv = false;
        if (ACT == 1 && u.pn >= split) { base = O1; colt -= split * BM; isv = true; }
        const int col0 = colt + wc * 32 + 8 * fq;
#pragma unroll
        for (int ai = 0; ai < 2; ++ai)
#pragma unroll
            for (int m = 0; m < 4; ++m) {
                const int r = row0 + ai * HALF + m * 16; const float rs = rstd_lds(R4, ai * HALF + wr * 64 + m * 16 + fr, 1.0f / 1024.0f); float ss = 0.f;
#pragma unroll
                for (int bj = 0; bj < 2; ++bj) { u32x4 w; f32x2 sv = (f32x2){0.f, 0.f};
#pragma unroll
                    for (int n = 0; n < 2; ++n)
#pragma unroll
                        for (int h = 0; h < 2; ++h) { f32x2 x = (f32x2){acc[ai][bj][m][n][2 * h], acc[ai][bj][m][n][2 * h + 1]} * rs;
                            if (ACT == 1) { const f32x2 k = (x * x) * (0.044715f * -2.3022082090378f) + (-2.3022082090378f), t = k * x; f32x2 e; e.x = __builtin_amdgcn_exp2f(t.x); e.y = __builtin_amdgcn_exp2f(t.y);
                                const f32x2 d = e + 1.0f; f32x2 rc; rc.x = __builtin_amdgcn_rcpf(d.x); rc.y = __builtin_amdgcn_rcpf(d.y); x = x * rc; sv = sv + x * x; }
                            w[2 * n + h] = cvt_pk_bf16(x.x, x.y); }
                    if (ACT == 1) ss += sv.x + sv.y;
                    *(u32x4*)(base + (size_t)r * ldc + col0 + bj * HALF) = w; }
                if (ACT == 1 && isv) { ss += __shfl_xor(ss, 16); ss += __shfl_xor(ss, 32); if (fq == 0) P[(ai * HALF + wr * 64 + m * 16 + fr) * 4 + wc] = ss; }
            }
        if (ACT == 1 && isv) {
            asm volatile("s_waitcnt lgkmcnt(0)" ::: "memory"); __builtin_amdgcn_s_barrier(); asm volatile("" ::: "memory");
            const int t = threadIdx.x;
            if (t < 256) { const f32x4 p = *(const PG8_LAS f32x4*)(P + t * 4); ssqv[(size_t)(u.pm * BM + t) * 8 + (u.pn - split)] = (p[0] + p[1]) + (p[2] + p[3]); }
        }
    }
};
struct EpiRes {
    static constexpr bool PERM = true, AFTER_DRAIN = false;
    bf16_t* xb; float* ssq; float alpha; PG8_LAS float* P;
    __device__ __forceinline__ void prefetch(const Unit&, int, int) const {}
    __device__ __forceinline__ void operator()(const f32x4 (&acc)[2][2][4][2], const Unit& u, int wr, int wc, int fr, int fq) const {
        const int row0 = u.pm * BM + wr * 64 + fr, col0 = u.pn * BM + wc * 32 + 8 * fq;
        u32x4 xo[2][4][2];
#pragma unroll
        for (int ai = 0; ai < 2; ++ai)
#pragma unroll
            for (int m = 0; m < 4; ++m)
#pragma unroll
                for (int bj = 0; bj < 2; ++bj) xo[ai][m][bj] = *(const u32x4*)(xb + (size_t)(row0 + ai * HALF + m * 16) * 1024 + col0 + bj * HALF);
#pragma unroll
        for (int ai = 0; ai < 2; ++ai) {
#pragma unroll
            for (int m = 0; m < 4; ++m) {
                const size_t off = (size_t)(row0 + ai * HALF + m * 16) * 1024 + col0; f32x2 sv = (f32x2){0.f, 0.f};
#pragma unroll
                for (int bj = 0; bj < 2; ++bj) { u32x4 w;
#pragma unroll
                    for (int n = 0; n < 2; ++n)
#pragma unroll
                        for (int h = 0; h < 2; ++h) { const unsigned xw = xo[ai][m][bj][2 * n + h]; const f32x2 a = (f32x2){__uint_as_float(xw << 16), __uint_as_float(xw & 0xffff0000u)};
                            const f32x2 v = a + (f32x2){acc[ai][bj][m][n][2 * h], acc[ai][bj][m][n][2 * h + 1]} * alpha; sv = sv + v * v; w[2 * n + h] = cvt_pk_bf16(v.x, v.y); }
                    *(u32x4*)(xb + off + bj * HALF) = w; }
                float ss = sv.x + sv.y; ss += __shfl_xor(ss, 16); ss += __shfl_xor(ss, 32); if (fq == 0) P[(ai * HALF + wr * 64 + m * 16 + fr) * 4 + wc] = ss;
            }
        }
        asm volatile("s_waitcnt lgkmcnt(0)" ::: "memory"); __builtin_amdgcn_s_barrier(); asm volatile("" ::: "memory");
        const int t = threadIdx.x;
        if (t < 256) { const f32x4 p = *(const PG8_LAS f32x4*)(P + t * 4); ssq[(size_t)(u.pm * BM + t) * 4 + u.pn] = (p[0] + p[1]) + (p[2] + p[3]); }
    }
};

template <class Epi, class Sched, bool ALIGN_EPI = false, bool SP2 = false>
__device__ __forceinline__ void gemm_phase(PG8_LAS unsigned char* lds, const Gemm g, const Sched& S, const Epi& E) {
    int tid_ = threadIdx.x; asm volatile("" : "+v"(tid_));
    const int tid = tid_, wid = __builtin_amdgcn_readfirstlane(tid >> 6), lane = tid & 63, wr = wid >> 2, wc = wid & 3, fr = lane & 15, fq = lane >> 4;
    const int K = g.K, nt = K / BK;
    unsigned voffA[2], voffB[2];
#pragma unroll
    for (int i = 0; i < 2; ++i) { int R, C; stage_rc(tid * 16 + i * 8192, R, C); const int Rb = Epi::PERM ? ((R & ~31) + perm32(R & 31)) : R;
        voffA[i] = (unsigned)(R * K + C) * 2u; voffB[i] = (unsigned)(Rb * K + C) * 2u; }
    const size_t kstep = (size_t)(BK * 2);
    const size_t hstep = (size_t)HALF * K * 2;
    const size_t tstep = 2 * hstep;
    const unsigned ldsw = (unsigned)wid * 1024u;
    const int aoff = lds_byte(wr * 64 + fr, fq * 8), boff = lds_byte(wc * 32 + fr, fq * 8);
#define PG8_SA(b, h) (((b) * 2 + (h)) * HTB)
#define PG8_SB(b, h) ((4 + (b) * 2 + (h)) * HTB)
#define PG8_STAGE(bufoff, gbase, voff) do { _Pragma("unroll") for (int _i = 0; _i < 2; ++_i) \
        __builtin_amdgcn_global_load_lds((const unsigned*)((const char*)(gbase) + (voff)[_i]), (PG8_LAS unsigned*)(lds + (bufoff) + ldsw + _i * 8192), 16, 0, 0); } while (0)
#define PG8_LDA(dst, b, h) do { _Pragma("unroll") for (int m = 0; m < 4; ++m) _Pragma("unroll") for (int k = 0; k < 2; ++k) dst[m][k] = *(const PG8_LAS bf16x8*)(lds + PG8_SA(b, h) + aoff + m * 2048 + k * 1024); } while (0)
#define PG8_LDB(dst, b, h) do { _Pragma("unroll") for (int n = 0; n < 2; ++n) _Pragma("unroll") for (int k = 0; k < 2; ++k) dst[n][k] = *(const PG8_LAS bf16x8*)(lds + PG8_SB(b, h) + boff + n * 2048 + k * 1024); } while (0)
#define PG8_MMA(ai, bj, At, Bt) do { __builtin_amdgcn_s_setprio(1); _Pragma("unroll") for (int m = 0; m < 4; ++m) _Pragma("unroll") for (int n = 0; n < 2; ++n) _Pragma("unroll") for (int k = 0; k < 2; ++k) \
        acc[ai][bj][m][n] = __builtin_amdgcn_mfma_f32_16x16x32_bf16(Bt[n][k], At[m][k], acc[ai][bj][m][n], 0, 0, 0); __builtin_amdgcn_s_setprio(0); } while (0)
#define PG8_WAIT_V(n) asm volatile("s_waitcnt vmcnt(" #n ")" ::: "memory")
#define PG8_WAIT_L(n) asm volatile("s_waitcnt lgkmcnt(" #n ")" ::: "memory")
#define PG8_BAR __builtin_amdgcn_s_barrier()
#define PG8_SCHED __builtin_amdgcn_sched_barrier(0)
    Unit cur, nxt; int ui = 0;
    if (!S.next(0, cur)) return;
    f32x4 acc[2][2][4][2];
#pragma unroll
    for (int a = 0; a < 2; ++a)
#pragma unroll
        for (int b = 0; b < 2; ++b)
#pragma unroll
            for (int m = 0; m < 4; ++m)
#pragma unroll
                for (int n = 0; n < 2; ++n) acc[a][b][m][n] = (f32x4){0.f, 0.f, 0.f, 0.f};
    bf16x8 At[4][2], B0[2][2], B1[2][2];
    const char* cA = (const char*)g.A + (size_t)cur.pm * tstep; const char* cB = (const char*)g.Bt + (size_t)cur.pn * tstep;
    S.a_ready(cur);
    if constexpr (SP2) {
        PG8_STAGE(PG8_SB(0, 0), cB, voffB); PG8_STAGE(PG8_SB(0, 1), cB + hstep, voffB); PG8_STAGE(PG8_SA(0, 0), cA, voffA); PG8_STAGE(PG8_SA(0, 1), cA + hstep, voffA);
        if (wr == 1) PG8_BAR;
        PG8_WAIT_V(2); PG8_BAR;
        PG8_STAGE(PG8_SB(1, 0), cB + kstep, voffB); PG8_STAGE(PG8_SA(1, 0), cA + kstep, voffA); PG8_STAGE(PG8_SB(1, 1), cB + hstep + kstep, voffB);
        PG8_WAIT_V(6); PG8_BAR;
    } else {
        PG8_STAGE(PG8_SB(0, 0), cB, voffB); PG8_STAGE(PG8_SA(0, 0), cA, voffA); PG8_STAGE(PG8_SB(0, 1), cB + hstep, voffB); PG8_STAGE(PG8_SA(0, 1), cA + hstep, voffA);
        if (wr == 1) PG8_BAR;
        PG8_WAIT_V(4); PG8_BAR;
        PG8_STAGE(PG8_SB(1, 0), cB + kstep, voffB); PG8_STAGE(PG8_SA(1, 0), cA + kstep, voffA); PG8_STAGE(PG8_SB(1, 1), cB + hstep + kstep, voffB);
        PG8_WAIT_V(6); PG8_BAR;
    }
    for (;;) {
        const bool has_next = S.next(ui + 1, nxt);
        const char* nA = has_next ? (const char*)g.A + (size_t)nxt.pm * tstep : cA; const char* nB = has_next ? (const char*)g.Bt + (size_t)nxt.pn * tstep : cB;
        for (int t = 0; t < nt; t += 2) {
            const bool last = (t == nt - 2);
            const char* a1 = cA + (size_t)(t + 1) * kstep;
            const char* a2 = last ? nA : cA + (size_t)(t + 2) * kstep; const char* b2 = last ? nB : cB + (size_t)(t + 2) * kstep;
            const char* a3 = a2 + kstep; const char* b3 = b2 + kstep;
            if (last && has_next) S.a_ready(nxt);
            if (last) E.prefetch(cur, wid, lane);
            if constexpr (SP2) {
            PG8_LDB(B0, 0, 0); PG8_LDB(B1, 0, 1); PG8_SCHED; PG8_LDA(At, 0, 0); PG8_STAGE(PG8_SA(1, 1), a1 + hstep, voffA);
            PG8_WAIT_V(8); PG8_WAIT_L(0); PG8_BAR; PG8_MMA(0, 0, At, B0); PG8_MMA(0, 1, At, B1); PG8_BAR; PG8_SCHED;
            PG8_LDA(At, 0, 1); PG8_STAGE(PG8_SB(0, 0), b2, voffB); PG8_STAGE(PG8_SB(0, 1), b2 + hstep, voffB); PG8_STAGE(PG8_SA(0, 0), a2, voffA);
            PG8_WAIT_V(8); PG8_WAIT_L(0); PG8_BAR; PG8_MMA(1, 0, At, B0); PG8_MMA(1, 1, At, B1); PG8_BAR; PG8_SCHED;
            PG8_LDB(B0, 1, 0); PG8_LDB(B1, 1, 1); PG8_SCHED; PG8_LDA(At, 1, 0); PG8_STAGE(PG8_SA(0, 1), a2 + hstep, voffA);
            PG8_WAIT_V(8); PG8_WAIT_L(0); PG8_BAR; PG8_MMA(0, 0, At, B0); PG8_MMA(0, 1, At, B1); PG8_BAR; PG8_SCHED;
            PG8_LDA(At, 1, 1); PG8_STAGE(PG8_SB(1, 0), b3, voffB); PG8_STAGE(PG8_SB(1, 1), b3 + hstep, voffB); PG8_STAGE(PG8_SA(1, 0), a3, voffA);
            PG8_WAIT_V(8); PG8_WAIT_L(0); PG8_BAR; PG8_MMA(1, 0, At, B0); PG8_MMA(1, 1, At, B1); PG8_BAR; PG8_SCHED;
            } else {
            PG8_LDB(B0, 0, 0); PG8_SCHED; PG8_LDA(At, 0, 0); PG8_STAGE(PG8_SA(1, 1), a1 + hstep, voffA);
            PG8_WAIT_L(8); PG8_BAR; PG8_WAIT_L(0); PG8_MMA(0, 0, At, B0); PG8_BAR; PG8_SCHED;
            PG8_LDB(B1, 0, 1); PG8_STAGE(PG8_SB(0, 0), b2, voffB);
            PG8_BAR; PG8_WAIT_L(0); PG8_MMA(0, 1, At, B1); PG8_BAR;
            PG8_LDA(At, 0, 1); PG8_STAGE(PG8_SA(0, 0), a2, voffA);
            PG8_BAR; PG8_WAIT_L(0); PG8_MMA(1, 0, At, B0); PG8_BAR; PG8_SCHED;
            PG8_STAGE(PG8_SB(0, 1), b2 + hstep, voffB);
            PG8_WAIT_V(6); PG8_BAR; PG8_MMA(1, 1, At, B1); PG8_BAR;
            PG8_LDB(B0, 1, 0); PG8_SCHED; PG8_LDA(At, 1, 0); PG8_STAGE(PG8_SA(0, 1), a2 + hstep, voffA);
            PG8_WAIT_L(8); PG8_BAR; PG8_WAIT_L(0); PG8_MMA(0, 0, At, B0); PG8_BAR; PG8_SCHED;
            PG8_LDB(B1, 1, 1); PG8_STAGE(PG8_SB(1, 0), b3, voffB);
            PG8_BAR; PG8_WAIT_L(0); PG8_MMA(0, 1, At, B1); PG8_BAR;
            PG8_LDA(At, 1, 1); PG8_STAGE(PG8_SA(1, 0), a3, voffA);
            PG8_BAR; PG8_WAIT_L(0); PG8_MMA(1, 0, At, B0); PG8_BAR; PG8_SCHED;
            PG8_STAGE(PG8_SB(1, 1), b3 + hstep, voffB);
            PG8_WAIT_V(6); PG8_BAR; PG8_MMA(1, 1, At, B1); PG8_BAR;
            }
        }
        if constexpr (ALIGN_EPI) { if (wr == 0) PG8_BAR; }
        if constexpr (!Epi::AFTER_DRAIN) { E(acc, cur, wr, wc, fr, fq); S.done(cur); }
        if (!has_next) break;
#pragma unroll
        for (int a = 0; a < 2; ++a)
#pragma unroll
            for (int b = 0; b < 2; ++b)
#pragma unroll
                for (int m = 0; m < 4; ++m)
#pragma unroll
                    for (int n = 0; n < 2; ++n) acc[a][b][m][n] = (f32x4){0.f, 0.f, 0.f, 0.f};
        cur = nxt; cA = nA; cB = nB; ++ui;
        if constexpr (ALIGN_EPI) { if (wr == 1) PG8_BAR; }
    }
    PG8_WAIT_V(0);
    if constexpr (!ALIGN_EPI) { if (wr == 0) PG8_BAR; }
    PG8_BAR;
    if constexpr (Epi::AFTER_DRAIN) { E.fused(acc, cur, wr, wc, fr, fq, lds, wid, lane); S.done(cur); }
#undef PG8_SA
#undef PG8_SB
#undef PG8_STAGE
#undef PG8_LDA
#undef PG8_LDB
#undef PG8_MMA
#undef PG8_WAIT_V
#undef PG8_WAIT_L
#undef PG8_BAR
#undef PG8_SCHED
}
}

namespace mk {
#define LAS __attribute__((address_space(3)))
typedef unsigned short bf16;
typedef float f32x4 __attribute__((ext_vector_type(4)));
typedef unsigned u32x4 __attribute__((ext_vector_type(4)));
typedef unsigned u32x2 __attribute__((ext_vector_type(2)));
typedef short bf16x8 __attribute__((ext_vector_type(8)));
constexpr int NWAVES = 8, NT = NWAVES * 64;
constexpr int T = 32768, SEQ = 2048, D = 1024, FF = 2816, AD = 2048, CH = 128, NH = 8;
constexpr float EPS = 1e-6f;
constexpr size_t MiB = 1u << 20;
constexpr size_t WS_CTL = 0;
constexpr size_t WS_SSQ = 1 * MiB;
constexpr size_t WS_SSQV = 2 * MiB;
constexpr size_t WS_WFI = 4 * MiB, WFI_SZ = 11 * MiB;
constexpr size_t WS_WFO = 48 * MiB, WFO_SZ = 5 * MiB + MiB / 2;
constexpr size_t WS_WAI = 70 * MiB;
constexpr size_t WS_WAO = 78 * MiB;
constexpr size_t WS_WBI = 82 * MiB;
constexpr size_t WS_WBC = 84 * MiB;
constexpr size_t WS_XB = 96 * MiB;
constexpr size_t WS_R = 160 * MiB;
constexpr size_t WS_END = 416 * MiB;
constexpr int RING_BYTES = 131072, P_OFF = RING_BYTES, MISC_OFF = RING_BYTES + 8192, LDS_BYTES = RING_BYTES + 8192 + 256;

__device__ __forceinline__ float bf2f(unsigned short b) { return __uint_as_float(((unsigned)b) << 16); }
__device__ __forceinline__ float bflo(unsigned w) { return __uint_as_float(w << 16); }
__device__ __forceinline__ float bfhi(unsigned w) { return __uint_as_float(w & 0xffff0000u); }
__device__ __forceinline__ unsigned pk2(float lo, float hi) { return pg8::cvt_pk_bf16(lo, hi); }
__device__ __forceinline__ float wave_sum(float v) {
#pragma unroll
    for (int o = 1; o < 64; o <<= 1) v += __shfl_xor(v, o);
    return v;
}
#define LDS_WAIT() asm volatile("s_waitcnt lgkmcnt(0)" ::: "memory")

__device__ __forceinline__ void tr_block(const float* W, int ldw, int K, int c0, int k0, bf16* WT, int r0, const float* ks, LAS float* scr, int lane) {
    float v[32];
    const float* src = W + (size_t)(k0 + (lane >> 5)) * ldw + c0 + (lane & 31);
#pragma unroll
    for (int i = 0; i < 32; ++i) v[i] = src[(size_t)(2 * i) * ldw];
    const int c = lane & 7;
    f32x4 s0 = (f32x4){1.f, 1.f, 1.f, 1.f}, s1 = s0;
    if (ks) { s0 = *(const f32x4*)(ks + k0 + 8 * c); s1 = *(const f32x4*)(ks + k0 + 8 * c + 4); }
#pragma unroll
    for (int i = 0; i < 32; ++i) scr[(2 * i + (lane >> 5)) * 33 + (lane & 31)] = v[i];
    LDS_WAIT(); asm volatile("" ::: "memory");
#pragma unroll
    for (int j = 0; j < 4; ++j) { const int n = (lane >> 3) + 8 * j; const LAS float* s = scr + (8 * c) * 33 + n;
        u32x4 o; o[0] = pk2(s[0 * 33] * s0[0], s[1 * 33] * s0[1]); o[1] = pk2(s[2 * 33] * s0[2], s[3 * 33] * s0[3]); o[2] = pk2(s[4 * 33] * s1[0], s[5 * 33] * s1[1]); o[3] = pk2(s[6 * 33] * s1[2], s[7 * 33] * s1[3]);
        *(u32x4*)(WT + (size_t)(r0 + n) * K + k0 + 8 * c) = o; }
    LDS_WAIT(); asm volatile("" ::: "memory");
}

struct Args { const float* in[15]; float* out; unsigned char* ws; };

__device__ __forceinline__ void prepass(const Args& a, LAS unsigned char* lds, int G, int bid) {
    const int tid = threadIdx.x, lane = tid & 63, wave = tid >> 6;
    LAS float* scr = (LAS float*)(lds + wave * 16384);
    const int gw = bid * NWAVES + wave, NGW = G * NWAVES;
    unsigned char* ws = a.ws;
    const float* ffn_norm = a.in[1]; const float* ffn_w_in = a.in[2]; const float* ffn_w_out = a.in[3]; const float* mix_norm = a.in[4];
    const float* a_w_in = a.in[5]; const float* a_w_out = a.in[9]; const float* b_w_in = a.in[10];
    constexpr int I_FI = (D / 64) * (2 * FF / 32), I_FO = (FF / 64) * (D / 32), I_AI = (D / 64) * (2 * AD / 32), I_AO = (AD / 64) * (D / 32), I_BI = (D / 64) * (D / 32);
    constexpr int NITEMS = 4 * I_FI + 4 * I_FO + I_AI + I_AO + I_BI;
    for (int it = gw; it < NITEMS; it += NGW) {
        int r = it;
        if (r < 4 * I_FI) { const int q = r / I_FI; r -= q * I_FI; const int nblk = 2 * FF / 32, kb = r / nblk, nb = r % nblk, n0 = nb * 32;
            const int pn = n0 >> 8, bj = (n0 >> 7) & 1, i0 = n0 & 127, c0 = (bj ? FF : 0) + 128 * pn + i0;
            tr_block(ffn_w_in + (size_t)q * D * 2 * FF, 2 * FF, D, c0, kb * 64, (bf16*)(ws + WS_WFI + q * WFI_SZ), n0, ffn_norm + q * D, scr, lane); continue; }
        r -= 4 * I_FI;
        if (r < 4 * I_FO) { const int q = r / I_FO; r -= q * I_FO; const int nblk = D / 32, kb = r / nblk, nb = r % nblk;
            tr_block(ffn_w_out + (size_t)q * FF * D, D, FF, nb * 32, kb * 64, (bf16*)(ws + WS_WFO + q * WFO_SZ), nb * 32, nullptr, scr, lane); continue; }
        r -= 4 * I_FO;
        if (r < I_AI) { const int nblk = 2 * AD / 32, kb = r / nblk, nb = r % nblk; tr_block(a_w_in, 2 * AD, D, nb * 32, kb * 64, (bf16*)(ws + WS_WAI), nb * 32, mix_norm, scr, lane); continue; }
        r -= I_AI;
        if (r < I_AO) { const int nblk = D / 32, kb = r / nblk, nb = r % nblk; tr_block(a_w_out, D, AD, nb * 32, kb * 64, (bf16*)(ws + WS_WAO), nb * 32, nullptr, scr, lane); continue; }
        r -= I_AO;
        { const int nblk = D / 32, kb = r / nblk, nb = r % nblk; tr_block(b_w_in, D, D, nb * 32, kb * 64, (bf16*)(ws + WS_WBI), nb * 32, mix_norm + D, scr, lane); }
    }
    { const float* w_grp = a.in[11]; const float* b_scale = a.in[12]; const float* b_w_out = a.in[13]; bf16* WT = (bf16*)(ws + WS_WBC);
      for (int gid = bid * NT + tid; gid < 1024 * 128; gid += G * NT) {
          const int n = gid & 1023, k0 = __builtin_amdgcn_readfirstlane((gid >> 10) * 8), g = k0 >> 8, c0 = k0 & 255;
          float acc[8];
#pragma unroll
          for (int j = 0; j < 8; ++j) acc[j] = 0.f;
          const float* gp = w_grp + ((size_t)g * 256 + c0) * 256;
          for (int d = 0; d < 256; d += 16) { float w[16];
#pragma unroll
              for (int u = 0; u < 16; ++u) w[u] = b_w_out[(size_t)(g * 256 + d + u) * D + n];
#pragma unroll
              for (int u = 0; u < 16; ++u) w[u] *= b_scale[g * 256 + d + u];
#pragma unroll
              for (int j = 0; j < 8; ++j)
#pragma unroll
                  for (int u = 0; u < 16; ++u) acc[j] += gp[j * 256 + d + u] * w[u]; }
          u32x4 o; o[0] = pk2(acc[0], acc[1]); o[1] = pk2(acc[2], acc[3]); o[2] = pk2(acc[4], acc[5]); o[3] = pk2(acc[6], acc[7]);
          *(u32x4*)(WT + (size_t)n * D + k0) = o; } }
    { const float* x = a.in[0]; bf16* xb = (bf16*)(ws + WS_XB); float* ssq = (float*)(ws + WS_SSQ);
      for (int m0 = gw * 4; m0 < T; m0 += NGW * 4) { f32x4 v[4][4]; float s[4];
#pragma unroll
          for (int r = 0; r < 4; ++r)
#pragma unroll
              for (int j = 0; j < 4; ++j) v[r][j] = ((const f32x4*)(x + (size_t)(m0 + r) * D) + lane)[64 * j];
#pragma unroll
          for (int r = 0; r < 4; ++r) { float t = 0.f;
#pragma unroll
              for (int j = 0; j < 4; ++j) t += (v[r][j][0] * v[r][j][0] + v[r][j][1] * v[r][j][1]) + (v[r][j][2] * v[r][j][2] + v[r][j][3] * v[r][j][3]);
              s[r] = wave_sum(t); }
#pragma unroll
          for (int r = 0; r < 4; ++r) { u32x2* o8 = (u32x2*)(xb + (size_t)(m0 + r) * D) + lane;
#pragma unroll
              for (int j = 0; j < 4; ++j) { u32x2 o; o[0] = pk2(v[r][j][0], v[r][j][1]); o[1] = pk2(v[r][j][2], v[r][j][3]); o8[64 * j] = o; }
              if (lane == 0) *(f32x4*)(ssq + (size_t)(m0 + r) * 4) = (f32x4){s[r], 0.f, 0.f, 0.f}; } } }
}

__device__ __forceinline__ void sgu_phase(LAS unsigned char* lds, bf16* U, const bf16* V, const float* ssqv, const float* vnorm, const float* wsp, const float* bsp, int G, int bid) {
    int tid_ = threadIdx.x; asm volatile("" : "+v"(tid_));
    const int tid = tid_, lane = tid & 63, w = __builtin_amdgcn_readfirstlane(tid >> 6);
    constexpr int VSTR = 516, WSTR = 272;
    LAS unsigned char* Vt = lds; LAS unsigned char* Wl = lds + 128 * VSTR; LAS float* RS = (LAS float*)(lds + 128 * VSTR + 128 * WSTR);
    constexpr int NITEMS = (T / CH) * NH;
    const int d0 = (tid & 31) * 8, srow = tid >> 5;
    int cur_head = -1; float gsc[8]; u32x4 vreg[8];
    int it = bid; if (it >= NITEMS) return;
    const int tl = lane & 15, q4 = lane >> 4;
    u32x4 ureg[8];
    { const int chunk = it >> 3, h = it & 7;
#pragma unroll
      for (int j = 0; j < 8; ++j) vreg[j] = *(const u32x4*)(V + (size_t)(chunk * CH + srow + 16 * j) * AD + h * 256 + d0);
#pragma unroll
      for (int tb = 0; tb < 8; ++tb) ureg[tb] = *(const u32x4*)(U + (size_t)(chunk * CH + tl + 16 * tb) * AD + h * 256 + 32 * w + 8 * q4); }
    for (; it < NITEMS; it += G) {
        const int chunk = it >> 3, h = it & 7;
        if (h != cur_head) {
            if (cur_head >= 0) __syncthreads();
            for (int q = tid; q < 2048; q += NT) { const int t = q >> 4, s0 = (q & 15) * 8; const float* src = wsp + ((size_t)h * CH + t) * CH + s0;
                f32x4 a = *(const f32x4*)src, b = *(const f32x4*)(src + 4);
#pragma unroll
                for (int e = 0; e < 4; ++e) { if (s0 + e > t) a[e] = 0.f; if (s0 + 4 + e > t) b[e] = 0.f; }
                u32x4 o; o[0] = pk2(a[0], a[1]); o[1] = pk2(a[2], a[3]); o[2] = pk2(b[0], b[1]); o[3] = pk2(b[2], b[3]);
                *(LAS u32x4*)(Wl + t * WSTR + s0 * 2) = o; }
#pragma unroll
            for (int e = 0; e < 8; ++e) gsc[e] = vnorm[h * 256 + d0 + e];
            cur_head = h;
        }
        if (tid < CH) { const float* p = ssqv + (size_t)(chunk * CH + tid) * 8; const f32x4 p0 = *(const f32x4*)p, p1 = *(const f32x4*)(p + 4);
            RS[tid] = __builtin_amdgcn_rsqf((((p0[0] + p0[1]) + (p0[2] + p0[3])) + ((p1[0] + p1[1]) + (p1[2] + p1[3]))) * (1.0f / AD) + EPS); }
        __syncthreads();
#pragma unroll
        for (int j = 0; j < 8; ++j) { const int s = srow + 16 * j; const float rs = RS[s]; const u32x4 v = vreg[j]; LAS unsigned* dst = (LAS unsigned*)(Vt + s * VSTR + d0 * 2);
#pragma unroll
            for (int i = 0; i < 4; ++i) dst[i] = pk2(bflo(v[i]) * rs * gsc[2 * i], bfhi(v[i]) * rs * gsc[2 * i + 1]); }
        __syncthreads();
        bf16* ubase = U + (size_t)(chunk * CH + tl) * AD + h * 256 + 32 * w + 8 * q4;
        u32x4 unext[8];
        { const int nx = it + G; if (nx < NITEMS) { const int nchunk = nx >> 3, nh = nx & 7;
#pragma unroll
            for (int j = 0; j < 8; ++j) vreg[j] = *(const u32x4*)(V + (size_t)(nchunk * CH + srow + 16 * j) * AD + nh * 256 + d0);
#pragma unroll
            for (int tb = 0; tb < 8; ++tb) unext[tb] = *(const u32x4*)(U + (size_t)(nchunk * CH + tl + 16 * tb) * AD + nh * 256 + 32 * w + 8 * q4); }
          else {
#pragma unroll
            for (int tb = 0; tb < 8; ++tb) unext[tb] = ureg[tb]; } }
        bf16x8 af[2][4];
#pragma unroll
        for (int db = 0; db < 2; ++db)
#pragma unroll
            for (int kb = 0; kb < 4; ++kb) { const LAS unsigned char* p = Vt + (32 * kb + 8 * q4) * VSTR + (32 * w + 8 * (tl >> 2) + 4 * db + (tl & 3)) * 2; u32x4 f;
#pragma unroll
                for (int e = 0; e < 4; ++e) f[e] = (unsigned)*(const LAS unsigned short*)(p + (2 * e) * VSTR) | ((unsigned)*(const LAS unsigned short*)(p + (2 * e + 1) * VSTR) << 16);
                af[db][kb] = __builtin_bit_cast(bf16x8, f); }
#pragma unroll
        for (int tb = 0; tb < 8; ++tb) {
            f32x4 c0 = (f32x4){0.f, 0.f, 0.f, 0.f}, c1 = (f32x4){0.f, 0.f, 0.f, 0.f};
#pragma unroll
            for (int kb = 0; kb <= (tb >> 1); ++kb) { const bf16x8 bfr = *(const LAS bf16x8*)(Wl + (16 * tb + tl) * WSTR + (32 * kb + 8 * q4) * 2);
                c0 = __builtin_amdgcn_mfma_f32_16x16x32_bf16(af[0][kb], bfr, c0, 0, 0, 0); c1 = __builtin_amdgcn_mfma_f32_16x16x32_bf16(af[1][kb], bfr, c1, 0, 0, 0); }
            const float bias = bsp[h * CH + 16 * tb + tl]; const u32x4 uu = ureg[tb]; u32x4 o;
            o[0] = pk2(bflo(uu[0]) * (c0[0] + bias), bfhi(uu[0]) * (c0[1] + bias)); o[1] = pk2(bflo(uu[1]) * (c0[2] + bias), bfhi(uu[1]) * (c0[3] + bias));
            o[2] = pk2(bflo(uu[2]) * (c1[0] + bias), bfhi(uu[2]) * (c1[1] + bias)); o[3] = pk2(bflo(uu[3]) * (c1[2] + bias), bfhi(uu[3]) * (c1[3] + bias));
            *(u32x4*)(ubase + (size_t)(16 * tb) * AD) = o;
        }
#pragma unroll
        for (int tb = 0; tb < 8; ++tb) ureg[tb] = unext[tb];
        __syncthreads();
    }
}

__device__ __forceinline__ void pool_phase(const bf16* Pm, bf16* Q, int G, int bid) {
    constexpr int RUN = 32;
    for (int gid = bid * NT + threadIdx.x; gid < (T / RUN) * (D / 8); gid += G * NT) {
        const int c8 = gid & 127, run = gid >> 7, t0 = run * RUN, pos0 = t0 & (SEQ - 1), w = 2 << (c8 >> 5);
        const bf16* src = Pm + (size_t)t0 * D + c8 * 8; bf16* dst = Q + (size_t)t0 * D + c8 * 8;
        float sum[8];
#pragma unroll
        for (int e = 0; e < 8; ++e) sum[e] = 0.f;
        for (int j = 1; j < w; ++j) if (pos0 - j >= 0) { const u32x4 v = *(const u32x4*)(src - (size_t)j * D);
#pragma unroll
            for (int i = 0; i < 4; ++i) { sum[2 * i] += bflo(v[i]); sum[2 * i + 1] += bfhi(v[i]); } }
#pragma unroll 4
        for (int t = 0; t < RUN; ++t) { const int pos = pos0 + t; const u32x4 v = *(const u32x4*)(src + (size_t)t * D); float cur[8];
#pragma unroll
            for (int i = 0; i < 4; ++i) { cur[2 * i] = bflo(v[i]); cur[2 * i + 1] = bfhi(v[i]); }
            const float inv = 1.0f / (float)(pos + 1 < w ? pos + 1 : w); u32x4 o;
#pragma unroll
            for (int e = 0; e < 8; ++e) sum[e] += cur[e];
#pragma unroll
            for (int i = 0; i < 4; ++i) o[i] = pk2(sum[2 * i] * inv - cur[2 * i], sum[2 * i + 1] * inv - cur[2 * i + 1]);
            *(u32x4*)(dst + (size_t)t * D) = o;
            if (pos - w + 1 >= 0) { const u32x4 ov = *(const u32x4*)(src + (ptrdiff_t)(t - w + 1) * D);
#pragma unroll
                for (int i = 0; i < 4; ++i) { sum[2 * i] -= bflo(ov[i]); sum[2 * i + 1] -= bfhi(ov[i]); } } }
    }
}

__device__ __forceinline__ void final_phase(float* out, const bf16* xb, const float* ssq, const float* gfin, int G, int bid) {
    const int lane = threadIdx.x & 63, gw = bid * NWAVES + (threadIdx.x >> 6), NGW = G * NWAVES;
    f32x4 g[4];
#pragma unroll
    for (int j = 0; j < 4; ++j) g[j] = *((const f32x4*)gfin + 2 * lane + 128 * (j >> 1) + (j & 1));
    for (int m0 = gw * 4; m0 < T; m0 += NGW * 4) { u32x4 v[4][2]; float rs[4];
#pragma unroll
        for (int r = 0; r < 4; ++r) { v[r][0] = ((const u32x4*)(xb + (size_t)(m0 + r) * D))[lane]; v[r][1] = ((const u32x4*)(xb + (size_t)(m0 + r) * D))[lane + 64]; rs[r] = pg8::rstd_row(ssq, m0 + r, 1.0f / D); }
#pragma unroll
        for (int r = 0; r < 4; ++r) { f32x4* o = (f32x4*)(out + (size_t)(m0 + r) * D);
#pragma unroll
            for (int q = 0; q < 2; ++q) { const u32x4 w = v[r][q];
                o[2 * lane + 128 * q] = (f32x4){bflo(w[0]), bfhi(w[0]), bflo(w[1]), bfhi(w[1])} * rs[r] * g[2 * q];
                o[2 * lane + 128 * q + 1] = (f32x4){bflo(w[2]), bfhi(w[2]), bflo(w[3]), bfhi(w[3])} * rs[r] * g[2 * q + 1]; } } }
}

#define XB_TMO      128
#define XB_XCNT(j)  (256  + 64 * (j))
#define XB_XSUB(j)  (1280 + 64 * (j))
#define XB_XGEN(j)  (2304 + 64 * (j))
#define XB_TOP      3328
#define XB_TOPGEN   3392
#define XCD_BAR_WORDS 3456
#define XB_SPIN_CAP (1u << 18)

__device__ __forceinline__ unsigned xb_ld(unsigned* p)              { return __hip_atomic_load(p, __ATOMIC_RELAXED, __HIP_MEMORY_SCOPE_AGENT); }
__device__ __forceinline__ unsigned xb_add(unsigned* p, unsigned v) { return __hip_atomic_fetch_add(p, v, __ATOMIC_RELAXED, __HIP_MEMORY_SCOPE_AGENT); }
__device__ __forceinline__ unsigned xb_xcc_id() { return (unsigned)__builtin_amdgcn_s_getreg((3 << 11) | 20) & 0xFu; }
#define XB_SPIN(cond, bar) do { unsigned _sp = 0; while (cond) { __builtin_amdgcn_s_sleep(1); \
    if ((++_sp & 255u) == 0u) { if (xb_ld(&(bar)[XB_TMO])) break; if (_sp > XB_SPIN_CAP) { atomicAdd(&(bar)[XB_TMO], 1u); break; } } } } while (0)

struct XcdBarrier {
    unsigned* bar; unsigned x;
    volatile LAS unsigned* st;
};

__device__ __forceinline__ XcdBarrier xcd_barrier_post(unsigned* bar, volatile LAS unsigned* st) {
    XcdBarrier b; b.bar = bar; b.x = xb_xcc_id(); b.st = st;
    if (threadIdx.x == 0) (void)xb_add(&bar[XB_XCNT(b.x)], 1u);
    return b;
}
__device__ __forceinline__ void xcd_barrier_complete(unsigned* bar, unsigned x, unsigned& nloc, unsigned& nx) {
    const unsigned G = gridDim.x * gridDim.y * gridDim.z;
    unsigned sum, cnt, mine, sp = 0u;
    for (;;) {
        sum = 0u; cnt = 0u; mine = 0u;
#pragma unroll
        for (unsigned j = 0; j < 16; ++j) { const unsigned c = xb_ld(&bar[XB_XCNT(j)]); sum += c; cnt += (c > 0u) ? 1u : 0u; mine = (j == x) ? c : mine; }
        if (sum == G) break;
        __builtin_amdgcn_s_sleep(1);
        if ((++sp & 255u) == 0u) { if (xb_ld(&bar[XB_TMO])) break; if (sp > XB_SPIN_CAP) { atomicAdd(&bar[XB_TMO], 1u); break; } }
    }
    nloc = mine > 0u ? mine : 1u; nx = cnt > 0u ? cnt : 1u;
}

__device__ __forceinline__ void xcd_barrier(const XcdBarrier& b) {
    asm volatile("s_waitcnt vmcnt(0)" ::: "memory");
    __syncthreads();
    if (threadIdx.x == 0) {
        unsigned* bar = b.bar;
        __builtin_amdgcn_s_waitcnt(0);
        unsigned nloc = b.st[0], nx = b.st[1];
        if (nloc == 0u) { xcd_barrier_complete(bar, b.x, nloc, nx); b.st[0] = nloc; b.st[1] = nx; }
        const unsigned old = xb_add(&bar[XB_XSUB(b.x)], 1u);
        const unsigned gen = old / nloc;
        if (old + 1u == (gen + 1u) * nloc) {
            __builtin_amdgcn_fence(__ATOMIC_RELEASE, "agent");
            asm volatile("s_waitcnt vmcnt(0)" ::: "memory");
            const unsigned og = xb_add(&bar[XB_TOP], 1u);
            const unsigned tg = og / nx;
            if (og + 1u == (tg + 1u) * nx) xb_add(&bar[XB_TOPGEN], 1u);
            else XB_SPIN(xb_ld(&bar[XB_TOPGEN]) == tg, bar);
            __builtin_amdgcn_fence(__ATOMIC_ACQUIRE, "agent");
            xb_add(&bar[XB_XGEN(b.x)], 1u);
            asm volatile("s_waitcnt vmcnt(0)" ::: "memory");
        } else {
            XB_SPIN(xb_ld(&bar[XB_XGEN(b.x)]) == gen, bar);
            __builtin_amdgcn_fence(__ATOMIC_ACQUIRE, "agent");
            asm volatile("s_waitcnt vmcnt(0)" ::: "memory");
        }
    }
    __syncthreads();
}

__device__ __forceinline__ const Args* kargs() { auto p = __builtin_amdgcn_kernarg_segment_ptr(); asm volatile("" : "+s"(p)); return (const Args*)p; }
#define MK_COMMON() const Args* ka = kargs(); unsigned char* ws = ka->ws; const int G = gridDim.x, bid = blockIdx.x; LAS unsigned char* lds = (LAS unsigned char*)lds_raw; PG8_LAS float* P = (PG8_LAS float*)(lds + P_OFF); (void)P
extern __shared__ __attribute__((aligned(16))) unsigned char lds_raw[];
template <int Q> __device__ __forceinline__ void ph_ffn_in() { MK_COMMON();
    pg8::Gemm g{(const bf16*)(ws + WS_XB), (const bf16*)(ws + WS_WFI + Q * WFI_SZ), T, 2 * FF, D}; pg8::StaticOrder S; S.init(T, 2 * FF, G, bid);
    pg8::EpiSwiGLU E{(bf16*)(ws + WS_R), FF, (const float*)(ws + WS_SSQ), P + 1024}; pg8::gemm_phase<pg8::EpiSwiGLU, pg8::StaticOrder, true, true>(lds, g, S, E); }
template <int Q> __device__ __forceinline__ void ph_ffn_out() { MK_COMMON();
    pg8::Gemm g{(const bf16*)(ws + WS_R), (const bf16*)(ws + WS_WFO + Q * WFO_SZ), T, D, FF}; pg8::StaticOrder S; S.init(T, D, G, bid);
    pg8::EpiRes E{(bf16*)(ws + WS_XB), (float*)(ws + WS_SSQ), 0.5f, P}; pg8::gemm_phase<pg8::EpiRes, pg8::StaticOrder, true, true>(lds, g, S, E); }
__device__ __forceinline__ void ph_a_in() { MK_COMMON();
    pg8::Gemm g{(const bf16*)(ws + WS_XB), (const bf16*)(ws + WS_WAI), T, 2 * AD, D}; pg8::StaticOrder S; S.init(T, 2 * AD, G, bid);
    pg8::EpiAct<1> E{(bf16*)(ws + WS_R), (bf16*)(ws + WS_R + 128 * MiB), AD, AD / 256, (const float*)(ws + WS_SSQ), (float*)(ws + WS_SSQV), P, P + 1024}; pg8::gemm_phase<pg8::EpiAct<1>, pg8::StaticOrder, true, true>(lds, g, S, E); }
__device__ __forceinline__ void ph_sgu() { MK_COMMON();
    sgu_phase(lds, (bf16*)(ws + WS_R), (const bf16*)(ws + WS_R + 128 * MiB), (const float*)(ws + WS_SSQV), ka->in[6], ka->in[7], ka->in[8], G, bid); }
template <int MIX> __device__ __forceinline__ void ph_mix_out() { MK_COMMON();
    pg8::Gemm g{(const bf16*)(ws + WS_R + (MIX ? 64 * MiB : 0)), (const bf16*)(ws + (MIX ? WS_WBC : WS_WAO)), T, D, MIX ? D : AD}; pg8::StaticOrder S; S.init(T, D, G, bid);
    pg8::EpiRes E{(bf16*)(ws + WS_XB), (float*)(ws + WS_SSQ), 1.0f, P}; pg8::gemm_phase<pg8::EpiRes, pg8::StaticOrder, true, true>(lds, g, S, E); }
__device__ __forceinline__ void ph_b_in() { MK_COMMON();
    pg8::Gemm g{(const bf16*)(ws + WS_XB), (const bf16*)(ws + WS_WBI), T, D, D}; pg8::StaticOrder S; S.init(T, D, G, bid);
    pg8::EpiAct<0> E{(bf16*)(ws + WS_R), (bf16*)(ws + WS_R), D, 0, (const float*)(ws + WS_SSQ), nullptr, P, P + 1024}; pg8::gemm_phase<pg8::EpiAct<0>, pg8::StaticOrder, true, true>(lds, g, S, E); }
__device__ __forceinline__ void ph_pool() { MK_COMMON(); pool_phase((const bf16*)(ws + WS_R), (bf16*)(ws + WS_R + 64 * MiB), G, bid); }
__device__ __forceinline__ void ph_final() { MK_COMMON(); final_phase(ka->out, (const bf16*)(ws + WS_XB), (const float*)(ws + WS_SSQ), ka->in[14], G, bid); }
__device__ __forceinline__ void ph_pre() { MK_COMMON(); prepass(*ka, lds, G, bid); }

__device__ __forceinline__ void seam_barrier() {
    const Args* ka = kargs(); XcdBarrier b; b.bar = (unsigned*)(ka->ws + WS_CTL); b.x = xb_xcc_id(); b.st = (volatile LAS unsigned*)((LAS unsigned char*)lds_raw + MISC_OFF);
    xcd_barrier(b);
}
template <int LO, int HI> __global__ void __launch_bounds__(NT, 2) fwd_megakernel(Args args) {
    cg::grid_group grid = cg::this_grid();
    { volatile LAS unsigned* st = (volatile LAS unsigned*)((LAS unsigned char*)lds_raw + MISC_OFF); if (threadIdx.x < 64) st[threadIdx.x] = 0u;
      if (blockIdx.x == 0) { unsigned* bar = (unsigned*)(args.ws + WS_CTL); for (int i = threadIdx.x; i < XCD_BAR_WORDS; i += NT) __hip_atomic_store(bar + i, 0u, __ATOMIC_RELAXED, __HIP_MEMORY_SCOPE_AGENT);
          asm volatile("s_waitcnt vmcnt(0)" ::: "memory"); }
      __syncthreads(); }
#define PH(k, call) do { if constexpr (LO <= (k) && (k) < HI) { call; if constexpr ((k) + 1 < HI) { if constexpr ((k) == LO) { grid.sync(); const Args* ka = kargs(); unsigned* bar = (unsigned*)(ka->ws + WS_CTL); \
        if (threadIdx.x == 0) (void)xb_add(&bar[XB_XCNT(xb_xcc_id())], 1u); } else seam_barrier(); } } } while (0)
    PH(0, ph_pre());
    PH(1, ph_ffn_in<0>());  PH(2, ph_ffn_out<0>());
    PH(3, ph_a_in());       PH(4, ph_sgu());          PH(5, ph_mix_out<0>());
    PH(6, ph_ffn_in<1>());  PH(7, ph_ffn_out<1>());
    PH(8, ph_ffn_in<2>());  PH(9, ph_ffn_out<2>());
    PH(10, ph_b_in());      PH(11, ph_pool());        PH(12, ph_mix_out<1>());
    PH(13, ph_ffn_in<3>()); PH(14, ph_ffn_out<3>());
    PH(15, ph_final());
#undef PH
}
constexpr int N_PHASES = 16;
}

extern "C" void kernel_launch(void* const* d_in, const int* in_sizes, int n_in, void* d_out, int out_size, void* d_ws, size_t ws_size, hipStream_t stream) {
    static int grid = 0;
    if (grid == 0) {
        if (n_in != 15 || in_sizes[0] != mk::T * mk::D || out_size != mk::T * mk::D || ws_size < mk::WS_END) { fprintf(stderr, "kernel_launch: unexpected shapes (n_in %d, in0 %d, out %d, ws %zu)\n", n_in, n_in > 0 ? in_sizes[0] : -1, out_size, ws_size); grid = -1; return; }
        int dev = 0, cus = 0, per_cu = 0;
        if (hipGetDevice(&dev) != hipSuccess || hipDeviceGetAttribute(&cus, hipDeviceAttributeMultiprocessorCount, dev) != hipSuccess) { grid = -1; return; }
        if (hipFuncSetAttribute((const void*)mk::fwd_megakernel<0, mk::N_PHASES>, hipFuncAttributeMaxDynamicSharedMemorySize, mk::LDS_BYTES) != hipSuccess) { fprintf(stderr, "kernel_launch: hipFuncSetAttribute failed\n"); grid = -1; return; }
        if (hipOccupancyMaxActiveBlocksPerMultiprocessor(&per_cu, (const void*)mk::fwd_megakernel<0, mk::N_PHASES>, mk::NT, mk::LDS_BYTES) != hipSuccess || per_cu < 1) { fprintf(stderr, "kernel_launch: occupancy query says %d\n", per_cu); per_cu = 1; }
        (void)hipGetLastError();
        grid = cus;
    }
    if (grid < 0) return;
    mk::Args a{};
    for (int i = 0; i < 15; ++i) a.in[i] = (const float*)d_in[i];
    a.out = (float*)d_out; a.ws = (unsigned char*)d_ws;
    void* kargs[] = {&a};
    hipError_t e = hipLaunchCooperativeKernel((const void*)mk::fwd_megakernel<0, mk::N_PHASES>, dim3(grid), dim3(mk::NT), kargs, mk::LDS_BYTES, stream);
    if (e != hipSuccess) fprintf(stderr, "kernel_launch: cooperative launch failed: %s (grid %d)\n", hipGetErrorString(e), grid);
}
```

```cpp
#include <hip/hip_runtime.h>
#include <hip/hip_cooperative_groups.h>
#include <cstdio>
#include <cstdint>
namespace cg = cooperative_groups;
namespace pg8 {
#define PG8_LAS __attribute__((address_space(3)))
typedef unsigned short bf16_t;
typedef short bf16x8 __attribute__((ext_vector_type(8)));
typedef float f32x4 __attribute__((ext_vector_type(4)));
typedef unsigned u32x4 __attribute__((ext_vector_type(4)));
constexpr int BM = 256, BK = 64, HALF = 128, HTB = HALF * BK * 2  , STAGE_BYTES = 8 * HTB, NXCD = 8, WGM = 8;

__host__ __device__ __forceinline__ int lds_byte(int r, int c) { const int st = (r >> 4) * 2 + (c >> 5), rr = r & 15, cc = c & 31, ob = rr * 64 + cc * 2; return st * 1024 + (ob ^ (((ob >> 9) & 1) << 5)); }
__host__ __device__ __forceinline__ void stage_rc(int b, int& R, int& C) { const int st = b / 1024, sb = b % 1024, swz = sb ^ (((sb >> 9) & 1) << 5); R = (st >> 1) * 16 + swz / 64; C = (st & 1) * 32 + (swz % 64) / 2; }
__host__ __device__ __forceinline__ int perm32(int rho) { const int n = rho >> 4, i = rho & 15; return 8 * (i >> 2) + 4 * n + (i & 3); }

struct Unit { int pm, pn; };
struct Gemm { const bf16_t* A; const bf16_t* Bt; int M, N, K; };

struct StaticOrder {
    int nM, nN, nwg, G, c;
    __host__ __device__ void init(int M, int N, int G_, int c_) { nM = M / BM; nN = N / BM; nwg = nM * nN; G = G_; c = c_; }
    __host__ __device__ bool next(int i, Unit& u) const {
        const long L = (long)i * G + c; if (L >= nwg) return false;
        int wgid = (int)L; { const int q = nwg / NXCD, r = nwg % NXCD, xcd = wgid % NXCD, off = wgid / NXCD; wgid = (xcd < r ? xcd * (q + 1) : r * (q + 1) + (xcd - r) * q) + off; }
        const int nig = WGM * nN, gid = wgid / nig, fm = gid * WGM, gsz = (nM - fm) < WGM ? (nM - fm) : WGM;
        u.pm = fm + ((wgid % nig) % gsz); u.pn = (wgid % nig) / gsz; return true;
    }
    __device__ __forceinline__ void a_ready(const Unit&) const {}
    __device__ __forceinline__ void done(const Unit&) const {}
};

__device__ __forceinline__ unsigned cvt_pk_bf16(float lo, float hi) { unsigned r; asm volatile("v_cvt_pk_bf16_f32 %0, %1, %2" : "=v"(r) : "v"(lo), "v"(hi)); return r; }
constexpr float EPS = 1e-6f;
typedef float f32x2 __attribute__((ext_vector_type(2)));
__device__ __forceinline__ float rstd_row(const float* ssq4, int row, float inv_n) {
    const f32x4 p = *(const f32x4*)(ssq4 + (size_t)row * 4);
    return __builtin_amdgcn_rsqf(((p[0] + p[1]) + (p[2] + p[3])) * inv_n + EPS);
}
__device__ __forceinline__ float rstd_lds(const PG8_LAS float* R4, int lrow, float inv_n) {
    const f32x4 p = *(const PG8_LAS f32x4*)(R4 + lrow * 4);
    return __builtin_amdgcn_rsqf(((p[0] + p[1]) + (p[2] + p[3])) * inv_n + EPS);
}
__device__ __forceinline__ void rows_prefetch(const float* ssq4, PG8_LAS float* R4, const Unit& u, int wid, int lane) {
    if (wid < 4) __builtin_amdgcn_global_load_lds((const unsigned*)(ssq4 + (size_t)(u.pm * BM + wid * 64 + lane) * 4), (PG8_LAS unsigned*)(R4 + wid * 256), 16, 0, 0);
}
__device__ __forceinline__ float silu_f(float g) { return g * __builtin_amdgcn_rcpf(1.0f + __builtin_amdgcn_exp2f(g * -1.4426950408889634f)); }
__device__ __forceinline__ float gelu_f(float x) { const float t = x * (1.0f + 0.044715f * x * x); return x * __builtin_amdgcn_rcpf(1.0f + __builtin_amdgcn_exp2f(t * -2.3022082090378f)); }

struct EpiSwiGLU {
    static constexpr bool PERM = true, AFTER_DRAIN = false;
    bf16_t* H; int ldh; const float* ssq; PG8_LAS float* R4;
    __device__ __forceinline__ void prefetch(const Unit& u, int wid, int lane) const { rows_prefetch(ssq, R4, u, wid, lane); }
    __device__ __forceinline__ void operator()(const f32x4 (&acc)[2][2][4][2], const Unit& u, int wr, int wc, int fr, int fq) const {
        const int row0 = u.pm * BM + wr * 64 + fr, col0 = u.pn * HALF + wc * 32 + 8 * fq;
        float rsv[2][4];
#pragma unroll
        for (int ai = 0; ai < 2; ++ai)
#pragma unroll
            for (int m = 0; m < 4; ++m) rsv[ai][m] = rstd_lds(R4, ai * HALF + wr * 64 + m * 16 + fr, 1.0f / 1024.0f);
#pragma unroll
        for (int ai = 0; ai < 2; ++ai)
#pragma unroll
            for (int m = 0; m < 4; ++m) {
                const int r = row0 + ai * HALF + m * 16; const float rs = rsv[ai][m];
                u32x4 w; const float cexp = rs * -1.4426950408889634f, rs2 = rs * rs;
#pragma unroll
                for (int n = 0; n < 2; ++n)
#pragma unroll
                    for (int h = 0; h < 2; ++h) { const f32x2 g = (f32x2){acc[ai][0][m][n][2 * h], acc[ai][0][m][n][2 * h + 1]}, up = (f32x2){acc[ai][1][m][n][2 * h], acc[ai][1][m][n][2 * h + 1]};
                        const f32x2 p = (g * up) * rs2, t = g * cexp; f32x2 e; e.x = __builtin_amdgcn_exp2f(t.x); e.y = __builtin_amdgcn_exp2f(t.y);
                        const f32x2 d = e + 1.0f; f32x2 rc; rc.x = __builtin_amdgcn_rcpf(d.x); rc.y = __builtin_amdgcn_rcpf(d.y); const f32x2 o = p * rc;
                        w[2 * n + h] = cvt_pk_bf16(o.x, o.y); }
                *(u32x4*)(H + (size_t)r * ldh + col0) = w;
            }
    }
};
template <int ACT> struct EpiAct {
    static constexpr bool PERM = true, AFTER_DRAIN = false;
    bf16_t* O0; bf16_t* O1; int ldc; int split; const float* ssq; float* ssqv; PG8_LAS float* P; PG8_LAS float* R4;
    __device__ __forceinline__ void prefetch(const Unit& u, int wid, int lane) const { rows_prefetch(ssq, R4, u, wid, lane); }
    __device__ __forceinline__ void operator()(const f32x4 (&acc)[2][2][4][2], const Unit& u, int wr, int wc, int fr, int fq) const {
        const int row0 = u.pm * BM + wr * 64 + fr; bf16_t* base = O0; int colt = u.pn * BM; bool isv = false;
        if (ACT == 1 && u.pn >= split) { base = O1; colt -= split * BM; isv = true; }
        const int col0 = colt + wc * 32 + 8 * fq;
        float rsv[2][4];
#pragma unroll
        for (int ai = 0; ai < 2; ++ai)
#pragma unroll
            for (int m = 0; m < 4; ++m) rsv[ai][m] = rstd_lds(R4, ai * HALF + wr * 64 + m * 16 + fr, 1.0f / 1024.0f);
#pragma unroll
        for (int ai = 0; ai < 2; ++ai)
#pragma unroll
            for (int m = 0; m < 4; ++m) {
                const int r = row0 + ai * HALF + m * 16; const float rs = rsv[ai][m]; float ss = 0.f;
#pragma unroll
                for (int bj = 0; bj < 2; ++bj) { u32x4 w; f32x2 sv = (f32x2){0.f, 0.f};
#pragma unroll
                    for (int n = 0; n < 2; ++n)
#pragma unroll
                        for (int h = 0; h < 2; ++h) { f32x2 x = (f32x2){acc[ai][bj][m][n][2 * h], acc[ai][bj][m][n][2 * h + 1]} * rs;
                            if (ACT == 1) { const f32x2 k = (x * x) * (0.044715f * -2.3022082090378f) + (-2.3022082090378f), t = k * x; f32x2 e; e.x = __builtin_amdgcn_exp2f(t.x); e.y = __builtin_amdgcn_exp2f(t.y);
                                const f32x2 d = e + 1.0f; f32x2 rc; rc.x = __builtin_amdgcn_rcpf(d.x); rc.y = __builtin_amdgcn_rcpf(d.y); x = x * rc; sv = sv + x * x; }
                            w[2 * n + h] = cvt_pk_bf16(x.x, x.y); }
                    if (ACT == 1) ss += sv.x + sv.y;
                    *(u32x4*)(base + (size_t)r * ldc + col0 + bj * HALF) = w; }
                if (ACT == 1 && isv) { ss += __shfl_xor(ss, 16); ss += __shfl_xor(ss, 32); if (fq == 0) P[(ai * HALF + wr * 64 + m * 16 + fr) * 4 + wc] = ss; }
            }
        if (ACT == 1 && isv) {
            asm volatile("s_waitcnt lgkmcnt(0)" ::: "memory"); __builtin_amdgcn_s_barrier(); asm volatile("" ::: "memory");
            const int t = threadIdx.x;
            if (t < 256) { const f32x4 p = *(const PG8_LAS f32x4*)(P + t * 4); ssqv[(size_t)(u.pm * BM + t) * 8 + (u.pn - split)] = (p[0] + p[1]) + (p[2] + p[3]); }
        }
    }
};
struct EpiRes {
    static constexpr bool PERM = true, AFTER_DRAIN = false;
    bf16_t* xb; float* ssq; float alpha; PG8_LAS float* P;
    __device__ __forceinline__ void prefetch(const Unit&, int, int) const {}
    __device__ __forceinline__ void operator()(const f32x4 (&acc)[2][2][4][2], const Unit& u, int wr, int wc, int fr, int fq) const {
        const int row0 = u.pm * BM + wr * 64 + fr, col0 = u.pn * BM + wc * 32 + 8 * fq;
#pragma unroll
        for (int ai = 0; ai < 2; ++ai) {
            u32x4 xo[4][2];
#pragma unroll
            for (int m = 0; m < 4; ++m)
#pragma unroll
                for (int bj = 0; bj < 2; ++bj) xo[m][bj] = *(const u32x4*)(xb + (size_t)(row0 + ai * HALF + m * 16) * 1024 + col0 + bj * HALF);
#pragma unroll
            for (int m = 0; m < 4; ++m) {
                const size_t off = (size_t)(row0 + ai * HALF + m * 16) * 1024 + col0; f32x2 sv = (f32x2){0.f, 0.f};
#pragma unroll
                for (int bj = 0; bj < 2; ++bj) { u32x4 w;
#pragma unroll
                    for (int n = 0; n < 2; ++n)
#pragma unroll
                        for (int h = 0; h < 2; ++h) { const unsigned xw = xo[m][bj][2 * n + h]; const f32x2 a = (f32x2){__uint_as_float(xw << 16), __uint_as_float(xw & 0xffff0000u)};
                            const f32x2 v = a + (f32x2){acc[ai][bj][m][n][2 * h], acc[ai][bj][m][n][2 * h + 1]} * alpha; sv = sv + v * v; w[2 * n + h] = cvt_pk_bf16(v.x, v.y); }
                    *(u32x4*)(xb + off + bj * HALF) = w; }
                float ss = sv.x + sv.y; ss += __shfl_xor(ss, 16); ss += __shfl_xor(ss, 32); if (fq == 0) P[(ai * HALF + wr * 64 + m * 16 + fr) * 4 + wc] = ss;
            }
            asm volatile("" ::: "memory");
        }
        asm volatile("s_waitcnt lgkmcnt(0)" ::: "memory"); __builtin_amdgcn_s_barrier(); asm volatile("" ::: "memory");
        const int t = threadIdx.x;
        if (t < 256) { const f32x4 p = *(const PG8_LAS f32x4*)(P + t * 4); ssq[(size_t)(u.pm * BM + t) * 4 + u.pn] = (p[0] + p[1]) + (p[2] + p[3]); }
    }
};

template <class Epi, class Sched, bool ALIGN_EPI = false, bool SP2 = false>
__device__ __forceinline__ void gemm_phase(PG8_LAS unsigned char* lds, const Gemm g, const Sched& S, const Epi& E) {
    int tid_ = threadIdx.x; asm volatile("" : "+v"(tid_));
    const int tid = tid_, wid = __builtin_amdgcn_readfirstlane(tid >> 6), lane = tid & 63, wr = wid >> 2, wc = wid & 3, fr = lane & 15, fq = lane >> 4;
    const int K = g.K, nt = K / BK;
    unsigned voffA[2], voffB[2];
#pragma unroll
    for (int i = 0; i < 2; ++i) { int R, C; stage_rc(tid * 16 + i * 8192, R, C); const int Rb = Epi::PERM ? ((R & ~31) + perm32(R & 31)) : R;
        voffA[i] = (unsigned)(R * K + C) * 2u; voffB[i] = (unsigned)(Rb * K + C) * 2u; }
    const size_t kstep = (size_t)(BK * 2);
    const size_t hstep = (size_t)HALF * K * 2;
    const size_t tstep = 2 * hstep;
    const unsigned ldsw = (unsigned)wid * 1024u;
    const int aoff = lds_byte(wr * 64 + fr, fq * 8), boff = lds_byte(wc * 32 + fr, fq * 8);
#define PG8_SA(b, h) (((b) * 2 + (h)) * HTB)
#define PG8_SB(b, h) ((4 + (b) * 2 + (h)) * HTB)
#define PG8_STAGE(bufoff, gbase, voff) do { _Pragma("unroll") for (int _i = 0; _i < 2; ++_i) \
        __builtin_amdgcn_global_load_lds((const unsigned*)((const char*)(gbase) + (voff)[_i]), (PG8_LAS unsigned*)(lds + (bufoff) + ldsw + _i * 8192), 16, 0, 0); } while (0)
#define PG8_LDA(dst, b, h) do { _Pragma("unroll") for (int m = 0; m < 4; ++m) _Pragma("unroll") for (int k = 0; k < 2; ++k) dst[m][k] = *(const PG8_LAS bf16x8*)(lds + PG8_SA(b, h) + aoff + m * 2048 + k * 1024); } while (0)
#define PG8_LDB(dst, b, h) do { _Pragma("unroll") for (int n = 0; n < 2; ++n) _Pragma("unroll") for (int k = 0; k < 2; ++k) dst[n][k] = *(const PG8_LAS bf16x8*)(lds + PG8_SB(b, h) + boff + n * 2048 + k * 1024); } while (0)
#define PG8_MMA(ai, bj, At, Bt) do { __builtin_amdgcn_s_setprio(1); _Pragma("unroll") for (int m = 0; m < 4; ++m) _Pragma("unroll") for (int n = 0; n < 2; ++n) _Pragma("unroll") for (int k = 0; k < 2; ++k) \
        acc[ai][bj][m][n] = __builtin_amdgcn_mfma_f32_16x16x32_bf16(Bt[n][k], At[m][k], acc[ai][bj][m][n], 0, 0, 0); __builtin_amdgcn_s_setprio(0); } while (0)
#define PG8_WAIT_V(n) asm volatile("s_waitcnt vmcnt(" #n ")" ::: "memory")
#define PG8_WAIT_L(n) asm volatile("s_waitcnt lgkmcnt(" #n ")" ::: "memory")
#define PG8_BAR __builtin_amdgcn_s_barrier()
#define PG8_SCHED __builtin_amdgcn_sched_barrier(0)
    Unit cur, nxt; int ui = 0;
    if (!S.next(0, cur)) return;
    f32x4 acc[2][2][4][2];
#pragma unroll
    for (int a = 0; a < 2; ++a)
#pragma unroll
        for (int b = 0; b < 2; ++b)
#pragma unroll
            for (int m = 0; m < 4; ++m)
#pragma unroll
                for (int n = 0; n < 2; ++n) acc[a][b][m][n] = (f32x4){0.f, 0.f, 0.f, 0.f};
    bf16x8 At[4][2], B0[2][2], B1[2][2];
    const char* cA = (const char*)g.A + (size_t)cur.pm * tstep; const char* cB = (const char*)g.Bt + (size_t)cur.pn * tstep;
    S.a_ready(cur);
    if constexpr (SP2) {
        PG8_STAGE(PG8_SB(0, 0), cB, voffB); PG8_STAGE(PG8_SB(0, 1), cB + hstep, voffB); PG8_STAGE(PG8_SA(0, 0), cA, voffA); PG8_STAGE(PG8_SA(0, 1), cA + hstep, voffA);
        if (wr == 1) PG8_BAR;
        PG8_WAIT_V(2); PG8_BAR;
        PG8_STAGE(PG8_SB(1, 0), cB + kstep, voffB); PG8_STAGE(PG8_SA(1, 0), cA + kstep, voffA); PG8_STAGE(PG8_SB(1, 1), cB + hstep + kstep, voffB);
        PG8_WAIT_V(6); PG8_BAR;
    } else {
        PG8_STAGE(PG8_SB(0, 0), cB, voffB); PG8_STAGE(PG8_SA(0, 0), cA, voffA); PG8_STAGE(PG8_SB(0, 1), cB + hstep, voffB); PG8_STAGE(PG8_SA(0, 1), cA + hstep, voffA);
        if (wr == 1) PG8_BAR;
        PG8_WAIT_V(4); PG8_BAR;
        PG8_STAGE(PG8_SB(1, 0), cB + kstep, voffB); PG8_STAGE(PG8_SA(1, 0), cA + kstep, voffA); PG8_STAGE(PG8_SB(1, 1), cB + hstep + kstep, voffB);
        PG8_WAIT_V(6); PG8_BAR;
    }
    for (;;) {
        const bool has_next = S.next(ui + 1, nxt);
        const char* nA = has_next ? (const char*)g.A + (size_t)nxt.pm * tstep : cA; const char* nB = has_next ? (const char*)g.Bt + (size_t)nxt.pn * tstep : cB;
        for (int t = 0; t < nt; t += 2) {
            const bool last = (t == nt - 2);
            const char* a1 = cA + (size_t)(t + 1) * kstep;
            const char* a2 = last ? nA : cA + (size_t)(t + 2) * kstep; const char* b2 = last ? nB : cB + (size_t)(t + 2) * kstep;
            const char* a3 = a2 + kstep; const char* b3 = b2 + kstep;
            if (last && has_next) S.a_ready(nxt);
            if (last) E.prefetch(cur, wid, lane);
            if constexpr (SP2) {
            PG8_LDB(B0, 0, 0); PG8_LDB(B1, 0, 1); PG8_SCHED; PG8_LDA(At, 0, 0); PG8_STAGE(PG8_SA(1, 1), a1 + hstep, voffA);
            PG8_WAIT_V(8); PG8_WAIT_L(0); PG8_BAR; PG8_MMA(0, 0, At, B0); PG8_MMA(0, 1, At, B1); PG8_BAR; PG8_SCHED;
            PG8_LDA(At, 0, 1); PG8_STAGE(PG8_SB(0, 0), b2, voffB); PG8_STAGE(PG8_SB(0, 1), b2 + hstep, voffB); PG8_STAGE(PG8_SA(0, 0), a2, voffA);
            PG8_WAIT_V(8); PG8_WAIT_L(0); PG8_BAR; PG8_MMA(1, 0, At, B0); PG8_MMA(1, 1, At, B1); PG8_BAR; PG8_SCHED;
            PG8_LDB(B0, 1, 0); PG8_LDB(B1, 1, 1); PG8_SCHED; PG8_LDA(At, 1, 0); PG8_STAGE(PG8_SA(0, 1), a2 + hstep, voffA);
            PG8_WAIT_V(8); PG8_WAIT_L(0); PG8_BAR; PG8_MMA(0, 0, At, B0); PG8_MMA(0, 1, At, B1); PG8_BAR; PG8_SCHED;
            PG8_LDA(At, 1, 1); PG8_STAGE(PG8_SB(1, 0), b3, voffB); PG8_STAGE(PG8_SB(1, 1), b3 + hstep, voffB); PG8_STAGE(PG8_SA(1, 0), a3, voffA);
            PG8_WAIT_V(8); PG8_WAIT_L(0); PG8_BAR; PG8_MMA(1, 0, At, B0); PG8_MMA(1, 1, At, B1); PG8_BAR; PG8_SCHED;
            } else {
            PG8_LDB(B0, 0, 0); PG8_SCHED; PG8_LDA(At, 0, 0); PG8_STAGE(PG8_SA(1, 1), a1 + hstep, voffA);
            PG8_WAIT_L(8); PG8_BAR; PG8_WAIT_L(0); PG8_MMA(0, 0, At, B0); PG8_BAR; PG8_SCHED;
            PG8_LDB(B1, 0, 1); PG8_STAGE(PG8_SB(0, 0), b2, voffB);
            PG8_BAR; PG8_WAIT_L(0); PG8_MMA(0, 1, At, B1); PG8_BAR;
            PG8_LDA(At, 0, 1); PG8_STAGE(PG8_SA(0, 0), a2, voffA);
            PG8_BAR; PG8_WAIT_L(0); PG8_MMA(1, 0, At, B0); PG8_BAR; PG8_SCHED;
            PG8_STAGE(PG8_SB(0, 1), b2 + hstep, voffB);
            PG8_WAIT_V(6); PG8_BAR; PG8_MMA(1, 1, At, B1); PG8_BAR;
            PG8_LDB(B0, 1, 0); PG8_SCHED; PG8_LDA(At, 1, 0); PG8_STAGE(PG8_SA(0, 1), a2 + hstep, voffA);
            PG8_WAIT_L(8); PG8_BAR; PG8_WAIT_L(0); PG8_MMA(0, 0, At, B0); PG8_BAR; PG8_SCHED;
            PG8_LDB(B1, 1, 1); PG8_STAGE(PG8_SB(1, 0), b3, voffB);
            PG8_BAR; PG8_WAIT_L(0); PG8_MMA(0, 1, At, B1); PG8_BAR;
            PG8_LDA(At, 1, 1); PG8_STAGE(PG8_SA(1, 0), a3, voffA);
            PG8_BAR; PG8_WAIT_L(0); PG8_MMA(1, 0, At, B0); PG8_BAR; PG8_SCHED;
            PG8_STAGE(PG8_SB(1, 1), b3 + hstep, voffB);
            PG8_WAIT_V(6); PG8_BAR; PG8_MMA(1, 1, At, B1); PG8_BAR;
            }
        }
        if constexpr (ALIGN_EPI) { if (wr == 0) PG8_BAR; }
        if constexpr (!Epi::AFTER_DRAIN) { E(acc, cur, wr, wc, fr, fq); S.done(cur); }
        if (!has_next) break;
#pragma unroll
        for (int a = 0; a < 2; ++a)
#pragma unroll
            for (int b = 0; b < 2; ++b)
#pragma unroll
                for (int m = 0; m < 4; ++m)
#pragma unroll
                    for (int n = 0; n < 2; ++n) acc[a][b][m][n] = (f32x4){0.f, 0.f, 0.f, 0.f};
        cur = nxt; cA = nA; cB = nB; ++ui;
        if constexpr (ALIGN_EPI) { if (wr == 1) PG8_BAR; }
    }
    PG8_WAIT_V(0);
    if constexpr (!ALIGN_EPI) { if (wr == 0) PG8_BAR; }
    PG8_BAR;
    if constexpr (Epi::AFTER_DRAIN) { E.fused(acc, cur, wr, wc, fr, fq, lds, wid, lane); S.done(cur); }
#undef PG8_SA
#undef PG8_SB
#undef PG8_STAGE
#undef PG8_LDA
#undef PG8_LDB
#undef PG8_MMA
#undef PG8_WAIT_V
#undef PG8_WAIT_L
#undef PG8_BAR
#undef PG8_SCHED
}
}

namespace mk {
#define LAS __attribute__((address_space(3)))
typedef unsigned short bf16;
typedef float f32x4 __attribute__((ext_vector_type(4)));
typedef unsigned u32x4 __attribute__((ext_vector_type(4)));
typedef unsigned u32x2 __attribute__((ext_vector_type(2)));
typedef short bf16x8 __attribute__((ext_vector_type(8)));
constexpr int NWAVES = 8, NT = NWAVES * 64;
constexpr int T = 32768, SEQ = 2048, D = 1024, FF = 2816, AD = 2048, CH = 128, NH = 8;
constexpr float EPS = 1e-6f;
constexpr size_t MiB = 1u << 20;
constexpr size_t WS_CTL = 0;
constexpr size_t WS_SSQ = 1 * MiB;
constexpr size_t WS_SSQV = 2 * MiB;
constexpr size_t WS_WFI = 4 * MiB, WFI_SZ = 11 * MiB;
constexpr size_t WS_WFO = 48 * MiB, WFO_SZ = 5 * MiB + MiB / 2;
constexpr size_t WS_WAI = 70 * MiB;
constexpr size_t WS_WAO = 78 * MiB;
constexpr size_t WS_WBI = 82 * MiB;
constexpr size_t WS_WBC = 84 * MiB;
constexpr size_t WS_XB = 96 * MiB;
constexpr size_t WS_R = 160 * MiB;
constexpr size_t WS_END = 416 * MiB;
constexpr int RING_BYTES = 131072, P_OFF = RING_BYTES, MISC_OFF = RING_BYTES + 8192, LDS_BYTES = RING_BYTES + 8192 + 256;

__device__ __forceinline__ float bf2f(unsigned short b) { return __uint_as_float(((unsigned)b) << 16); }
__device__ __forceinline__ float bflo(unsigned w) { return __uint_as_float(w << 16); }
__device__ __forceinline__ float bfhi(unsigned w) { return __uint_as_float(w & 0xffff0000u); }
__device__ __forceinline__ unsigned pk2(float lo, float hi) { return pg8::cvt_pk_bf16(lo, hi); }
__device__ __forceinline__ float wave_sum(float v) {
#pragma unroll
    for (int o = 1; o < 64; o <<= 1) v += __shfl_xor(v, o);
    return v;
}
#define LDS_WAIT() asm volatile("s_waitcnt lgkmcnt(0)" ::: "memory")

__device__ __forceinline__ void tr_block(const float* W, int ldw, int K, int c0, int k0, bf16* WT, int r0, const float* ks, LAS float* scr, int lane) {
    float v[32];
    const float* src = W + (size_t)(k0 + (lane >> 5)) * ldw + c0 + (lane & 31);
#pragma unroll
    for (int i = 0; i < 32; ++i) v[i] = src[(size_t)(2 * i) * ldw];
    const int c = lane & 7;
    f32x4 s0 = (f32x4){1.f, 1.f, 1.f, 1.f}, s1 = s0;
    if (ks) { s0 = *(const f32x4*)(ks + k0 + 8 * c); s1 = *(const f32x4*)(ks + k0 + 8 * c + 4); }
#pragma unroll
    for (int i = 0; i < 32; ++i) scr[(2 * i + (lane >> 5)) * 33 + (lane & 31)] = v[i];
    LDS_WAIT(); asm volatile("" ::: "memory");
#pragma unroll
    for (int j = 0; j < 4; ++j) { const int n = (lane >> 3) + 8 * j; const LAS float* s = scr + (8 * c) * 33 + n;
        u32x4 o; o[0] = pk2(s[0 * 33] * s0[0], s[1 * 33] * s0[1]); o[1] = pk2(s[2 * 33] * s0[2], s[3 * 33] * s0[3]); o[2] = pk2(s[4 * 33] * s1[0], s[5 * 33] * s1[1]); o[3] = pk2(s[6 * 33] * s1[2], s[7 * 33] * s1[3]);
        *(u32x4*)(WT + (size_t)(r0 + n) * K + k0 + 8 * c) = o; }
    LDS_WAIT(); asm volatile("" ::: "memory");
}

struct Args { const float* in[15]; float* out; unsigned char* ws; };

__device__ __forceinline__ void prepass(const Args& a, LAS unsigned char* lds, int G, int bid) {
    const int tid = threadIdx.x, lane = tid & 63, wave = tid >> 6;
    LAS float* scr = (LAS float*)(lds + wave * 16384);
    const int gw = bid * NWAVES + wave, NGW = G * NWAVES;
    unsigned char* ws = a.ws;
    const float* ffn_norm = a.in[1]; const float* ffn_w_in = a.in[2]; const float* ffn_w_out = a.in[3]; const float* mix_norm = a.in[4];
    const float* a_w_in = a.in[5]; const float* a_w_out = a.in[9]; const float* b_w_in = a.in[10];
    constexpr int I_FI = (D / 64) * (2 * FF / 32), I_FO = (FF / 64) * (D / 32), I_AI = (D / 64) * (2 * AD / 32), I_AO = (AD / 64) * (D / 32), I_BI = (D / 64) * (D / 32);
    constexpr int NITEMS = 4 * I_FI + 4 * I_FO + I_AI + I_AO + I_BI;
    for (int it = gw; it < NITEMS; it += NGW) {
        int r = it;
        if (r < 4 * I_FI) { const int q = r / I_FI; r -= q * I_FI; const int nblk = 2 * FF / 32, kb = r / nblk, nb = r % nblk, n0 = nb * 32;
            const int pn = n0 >> 8, bj = (n0 >> 7) & 1, i0 = n0 & 127, c0 = (bj ? FF : 0) + 128 * pn + i0;
            tr_block(ffn_w_in + (size_t)q * D * 2 * FF, 2 * FF, D, c0, kb * 64, (bf16*)(ws + WS_WFI + q * WFI_SZ), n0, ffn_norm + q * D, scr, lane); continue; }
        r -= 4 * I_FI;
        if (r < 4 * I_FO) { const int q = r / I_FO; r -= q * I_FO; const int nblk = D / 32, kb = r / nblk, nb = r % nblk;
            tr_block(ffn_w_out + (size_t)q * FF * D, D, FF, nb * 32, kb * 64, (bf16*)(ws + WS_WFO + q * WFO_SZ), nb * 32, nullptr, scr, lane); continue; }
        r -= 4 * I_FO;
        if (r < I_AI) { const int nblk = 2 * AD / 32, kb = r / nblk, nb = r % nblk; tr_block(a_w_in, 2 * AD, D, nb * 32, kb * 64, (bf16*)(ws + WS_WAI), nb * 32, mix_norm, scr, lane); continue; }
        r -= I_AI;
        if (r < I_AO) { const int nblk = D / 32, kb = r / nblk, nb = r % nblk; tr_block(a_w_out, D, AD, nb * 32, kb * 64, (bf16*)(ws + WS_WAO), nb * 32, nullptr, scr, lane); continue; }
        r -= I_AO;
        { const int nblk = D / 32, kb = r / nblk, nb = r % nblk; tr_block(b_w_in, D, D, nb * 32, kb * 64, (bf16*)(ws + WS_WBI), nb * 32, mix_norm + D, scr, lane); }
    }
    { const float* w_grp = a.in[11]; const float* b_scale = a.in[12]; const float* b_w_out = a.in[13]; bf16* WT = (bf16*)(ws + WS_WBC);
      for (int gid = bid * NT + tid; gid < 1024 * 128; gid += G * NT) {
          const int n = gid & 1023, k0 = __builtin_amdgcn_readfirstlane((gid >> 10) * 8), g = k0 >> 8, c0 = k0 & 255;
          float acc[8];
#pragma unroll
          for (int j = 0; j < 8; ++j) acc[j] = 0.f;
          const float* gp = w_grp + ((size_t)g * 256 + c0) * 256;
          for (int d = 0; d < 256; d += 16) { float w[16];
#pragma unroll
              for (int u = 0; u < 16; ++u) w[u] = b_w_out[(size_t)(g * 256 + d + u) * D + n];
#pragma unroll
              for (int u = 0; u < 16; ++u) w[u] *= b_scale[g * 256 + d + u];
#pragma unroll
              for (int j = 0; j < 8; ++j)
#pragma unroll
                  for (int u = 0; u < 16; ++u) acc[j] += gp[j * 256 + d + u] * w[u]; }
          u32x4 o; o[0] = pk2(acc[0], acc[1]); o[1] = pk2(acc[2], acc[3]); o[2] = pk2(acc[4], acc[5]); o[3] = pk2(acc[6], acc[7]);
          *(u32x4*)(WT + (size_t)n * D + k0) = o; } }
    { const float* x = a.in[0]; bf16* xb = (bf16*)(ws + WS_XB); float* ssq = (float*)(ws + WS_SSQ);
      for (int m0 = gw * 4; m0 < T; m0 += NGW * 4) { f32x4 v[4][4]; float s[4];
#pragma unroll
          for (int r = 0; r < 4; ++r)
#pragma unroll
              for (int j = 0; j < 4; ++j) v[r][j] = ((const f32x4*)(x + (size_t)(m0 + r) * D) + lane)[64 * j];
#pragma unroll
          for (int r = 0; r < 4; ++r) { float t = 0.f;
#pragma unroll
              for (int j = 0; j < 4; ++j) t += (v[r][j][0] * v[r][j][0] + v[r][j][1] * v[r][j][1]) + (v[r][j][2] * v[r][j][2] + v[r][j][3] * v[r][j][3]);
              s[r] = wave_sum(t); }
#pragma unroll
          for (int r = 0; r < 4; ++r) { u32x2* o8 = (u32x2*)(xb + (size_t)(m0 + r) * D) + lane;
#pragma unroll
              for (int j = 0; j < 4; ++j) { u32x2 o; o[0] = pk2(v[r][j][0], v[r][j][1]); o[1] = pk2(v[r][j][2], v[r][j][3]); o8[64 * j] = o; }
              if (lane == 0) *(f32x4*)(ssq + (size_t)(m0 + r) * 4) = (f32x4){s[r], 0.f, 0.f, 0.f}; } } }
}

__device__ __forceinline__ void sgu_phase(LAS unsigned char* lds, bf16* U, const bf16* V, const float* ssqv, const float* vnorm, const float* wsp, const float* bsp, int G, int bid) {
    int tid_ = threadIdx.x; asm volatile("" : "+v"(tid_));
    const int tid = tid_, lane = tid & 63, w = __builtin_amdgcn_readfirstlane(tid >> 6);
    constexpr int VSTR = 516, WSTR = 272;
    LAS unsigned char* Vt = lds; LAS unsigned char* Wl = lds + 128 * VSTR; LAS float* RS = (LAS float*)(lds + 128 * VSTR + 128 * WSTR);
    constexpr int NITEMS = (T / CH) * NH;
    const int d0 = (tid & 31) * 8, srow = tid >> 5;
    int cur_head = -1; float gsc[8]; u32x4 vreg[8];
    int it = bid; if (it >= NITEMS) return;
    const int tl = lane & 15, q4 = lane >> 4;
    u32x4 ureg[8]; f32x4 sq0 = (f32x4){0.f, 0.f, 0.f, 0.f}, sq1 = sq0;
    if (tid < CH) { const float* p = ssqv + (size_t)((it >> 3) * CH + tid) * 8; sq0 = *(const f32x4*)p; sq1 = *(const f32x4*)(p + 4); }
    { const int chunk = it >> 3, h = it & 7;
#pragma unroll
      for (int j = 0; j < 8; ++j) vreg[j] = *(const u32x4*)(V + (size_t)(chunk * CH + srow + 16 * j) * AD + h * 256 + d0);
#pragma unroll
      for (int tb = 0; tb < 8; ++tb) ureg[tb] = *(const u32x4*)(U + (size_t)(chunk * CH + tl + 16 * tb) * AD + h * 256 + 32 * w + 8 * q4); }
    for (; it < NITEMS; it += G) {
        const int chunk = it >> 3, h = it & 7;
        if (h != cur_head) {
            if (cur_head >= 0) __syncthreads();
            for (int q = tid; q < 2048; q += NT) { const int t = q >> 4, s0 = (q & 15) * 8; const float* src = wsp + ((size_t)h * CH + t) * CH + s0;
                f32x4 a = *(const f32x4*)src, b = *(const f32x4*)(src + 4);
#pragma unroll
                for (int e = 0; e < 4; ++e) { if (s0 + e > t) a[e] = 0.f; if (s0 + 4 + e > t) b[e] = 0.f; }
                u32x4 o; o[0] = pk2(a[0], a[1]); o[1] = pk2(a[2], a[3]); o[2] = pk2(b[0], b[1]); o[3] = pk2(b[2], b[3]);
                *(LAS u32x4*)(Wl + t * WSTR + s0 * 2) = o; }
#pragma unroll
            for (int e = 0; e < 8; ++e) gsc[e] = vnorm[h * 256 + d0 + e];
            cur_head = h;
        }
        if (tid < CH) RS[tid] = __builtin_amdgcn_rsqf((((sq0[0] + sq0[1]) + (sq0[2] + sq0[3])) + ((sq1[0] + sq1[1]) + (sq1[2] + sq1[3]))) * (1.0f / AD) + EPS);
        __syncthreads();
#pragma unroll
        for (int j = 0; j < 8; ++j) { const int s = srow + 16 * j; const float rs = RS[s]; const u32x4 v = vreg[j]; LAS unsigned* dst = (LAS unsigned*)(Vt + s * VSTR + d0 * 2);
#pragma unroll
            for (int i = 0; i < 4; ++i) dst[i] = pk2(bflo(v[i]) * rs * gsc[2 * i], bfhi(v[i]) * rs * gsc[2 * i + 1]); }
        __syncthreads();
        bf16* ubase = U + (size_t)(chunk * CH + tl) * AD + h * 256 + 32 * w + 8 * q4;
        u32x4 unext[8];
        { const int nx = it + G; if (nx < NITEMS) { const int nchunk = nx >> 3, nh = nx & 7;
            if (tid < CH) { const float* p = ssqv + (size_t)(nchunk * CH + tid) * 8; sq0 = *(const f32x4*)p; sq1 = *(const f32x4*)(p + 4); }
#pragma unroll
            for (int j = 0; j < 8; ++j) vreg[j] = *(const u32x4*)(V + (size_t)(nchunk * CH + srow + 16 * j) * AD + nh * 256 + d0);
#pragma unroll
            for (int tb = 0; tb < 8; ++tb) unext[tb] = *(const u32x4*)(U + (size_t)(nchunk * CH + tl + 16 * tb) * AD + nh * 256 + 32 * w + 8 * q4); }
          else {
#pragma unroll
            for (int tb = 0; tb < 8; ++tb) unext[tb] = ureg[tb]; } }
        bf16x8 af[2][4];
#pragma unroll
        for (int db = 0; db < 2; ++db)
#pragma unroll
            for (int kb = 0; kb < 4; ++kb) { const LAS unsigned char* p = Vt + (32 * kb + 8 * q4) * VSTR + (32 * w + 8 * (tl >> 2) + 4 * db + (tl & 3)) * 2; u32x4 f;
#pragma unroll
                for (int e = 0; e < 4; ++e) f[e] = (unsigned)*(const LAS unsigned short*)(p + (2 * e) * VSTR) | ((unsigned)*(const LAS unsigned short*)(p + (2 * e + 1) * VSTR) << 16);
                af[db][kb] = __builtin_bit_cast(bf16x8, f); }
#pragma unroll
        for (int tb = 0; tb < 8; ++tb) {
            f32x4 c0 = (f32x4){0.f, 0.f, 0.f, 0.f}, c1 = (f32x4){0.f, 0.f, 0.f, 0.f};
#pragma unroll
            for (int kb = 0; kb <= (tb >> 1); ++kb) { const bf16x8 bfr = *(const LAS bf16x8*)(Wl + (16 * tb + tl) * WSTR + (32 * kb + 8 * q4) * 2);
                c0 = __builtin_amdgcn_mfma_f32_16x16x32_bf16(af[0][kb], bfr, c0, 0, 0, 0); c1 = __builtin_amdgcn_mfma_f32_16x16x32_bf16(af[1][kb], bfr, c1, 0, 0, 0); }
            const float bias = bsp[h * CH + 16 * tb + tl]; const u32x4 uu = ureg[tb]; u32x4 o;
            o[0] = pk2(bflo(uu[0]) * (c0[0] + bias), bfhi(uu[0]) * (c0[1] + bias)); o[1] = pk2(bflo(uu[1]) * (c0[2] + bias), bfhi(uu[1]) * (c0[3] + bias));
            o[2] = pk2(bflo(uu[2]) * (c1[0] + bias), bfhi(uu[2]) * (c1[1] + bias)); o[3] = pk2(bflo(uu[3]) * (c1[2] + bias), bfhi(uu[3]) * (c1[3] + bias));
            *(u32x4*)(ubase + (size_t)(16 * tb) * AD) = o;
        }
#pragma unroll
        for (int tb = 0; tb < 8; ++tb) ureg[tb] = unext[tb];
        __syncthreads();
    }
}

__device__ __forceinline__ void pool_phase(const bf16* __restrict__ Pm, bf16* __restrict__ Q, int G, int bid) {
    constexpr int RUN = 32;
    for (int gid = bid * NT + threadIdx.x; gid < (T / RUN) * (D / 8); gid += G * NT) {
        const int c8 = gid & 127, run = gid >> 7, t0 = run * RUN, pos0 = t0 & (SEQ - 1), w = 2 << (c8 >> 5);
        const bf16* src = Pm + (size_t)t0 * D + c8 * 8; bf16* dst = Q + (size_t)t0 * D + c8 * 8;
        float sum[8];
#pragma unroll
        for (int e = 0; e < 8; ++e) sum[e] = 0.f;
        { u32x4 hv[15];
#pragma unroll
          for (int j = 1; j < 16; ++j) { const int jj = j <= pos0 ? j : pos0; hv[j - 1] = *(const u32x4*)(src - (size_t)jj * D); }
#pragma unroll
          for (int j = 1; j < 16; ++j) { const float m = (j < w && j <= pos0) ? 1.0f : 0.0f;
#pragma unroll
              for (int i = 0; i < 4; ++i) { sum[2 * i] += m * bflo(hv[j - 1][i]); sum[2 * i + 1] += m * bfhi(hv[j - 1][i]); } } }
        for (int tb = 0; tb < RUN; tb += 8) {
            u32x4 cv[8], ov[8];
#pragma unroll
            for (int t = 0; t < 8; ++t) { cv[t] = *(const u32x4*)(src + (size_t)(tb + t) * D);
                const int back = tb + t - w + 1, bb = (pos0 + back >= 0) ? back : -pos0;
                ov[t] = *(const u32x4*)(src + (ptrdiff_t)bb * D); }
#pragma unroll
            for (int t = 0; t < 8; ++t) { const int pos = pos0 + tb + t; float cur[8];
#pragma unroll
                for (int i = 0; i < 4; ++i) { cur[2 * i] = bflo(cv[t][i]); cur[2 * i + 1] = bfhi(cv[t][i]); }
                const float inv = 1.0f / (float)(pos + 1 < w ? pos + 1 : w); u32x4 o;
#pragma unroll
                for (int e = 0; e < 8; ++e) sum[e] += cur[e];
#pragma unroll
                for (int i = 0; i < 4; ++i) o[i] = pk2(sum[2 * i] * inv - cur[2 * i], sum[2 * i + 1] * inv - cur[2 * i + 1]);
                *(u32x4*)(dst + (size_t)(tb + t) * D) = o;
                const float m = (pos - w + 1 >= 0) ? 1.0f : 0.0f;
#pragma unroll
                for (int i = 0; i < 4; ++i) { sum[2 * i] -= m * bflo(ov[t][i]); sum[2 * i + 1] -= m * bfhi(ov[t][i]); } }
        }
    }
}

__device__ __forceinline__ void final_phase(float* out, const bf16* xb, const float* ssq, const float* gfin, int G, int bid) {
    const int lane = threadIdx.x & 63, gw = bid * NWAVES + (threadIdx.x >> 6), NGW = G * NWAVES;
    f32x4 g[4];
#pragma unroll
    for (int j = 0; j < 4; ++j) g[j] = *((const f32x4*)gfin + 2 * lane + 128 * (j >> 1) + (j & 1));
    for (int m0 = gw * 4; m0 < T; m0 += NGW * 4) { u32x4 v[4][2]; float rs[4];
#pragma unroll
        for (int r = 0; r < 4; ++r) { v[r][0] = ((const u32x4*)(xb + (size_t)(m0 + r) * D))[lane]; v[r][1] = ((const u32x4*)(xb + (size_t)(m0 + r) * D))[lane + 64]; rs[r] = pg8::rstd_row(ssq, m0 + r, 1.0f / D); }
#pragma unroll
        for (int r = 0; r < 4; ++r) { f32x4* o = (f32x4*)(out + (size_t)(m0 + r) * D);
#pragma unroll
            for (int q = 0; q < 2; ++q) { const u32x4 w = v[r][q];
                o[2 * lane + 128 * q] = (f32x4){bflo(w[0]), bfhi(w[0]), bflo(w[1]), bfhi(w[1])} * rs[r] * g[2 * q];
                o[2 * lane + 128 * q + 1] = (f32x4){bflo(w[2]), bfhi(w[2]), bflo(w[3]), bfhi(w[3])} * rs[r] * g[2 * q + 1]; } } }
}

#define XB_TMO      128
#define XB_XCNT(j)  (256  + 64 * (j))
#define XB_XSUB(j)  (1280 + 64 * (j))
#define XB_XGEN(j)  (2304 + 64 * (j))
#define XB_TOP      3328
#define XB_TOPGEN   3392
#define XCD_BAR_WORDS 3456
#define XB_SPIN_CAP (1u << 18)

__device__ __forceinline__ unsigned xb_ld(unsigned* p)              { return __hip_atomic_load(p, __ATOMIC_RELAXED, __HIP_MEMORY_SCOPE_AGENT); }
__device__ __forceinline__ unsigned xb_add(unsigned* p, unsigned v) { return __hip_atomic_fetch_add(p, v, __ATOMIC_RELAXED, __HIP_MEMORY_SCOPE_AGENT); }
__device__ __forceinline__ unsigned xb_xcc_id() { return (unsigned)__builtin_amdgcn_s_getreg((3 << 11) | 20) & 0xFu; }
#define XB_SPIN(cond, bar) do { unsigned _sp = 0; while (cond) { __builtin_amdgcn_s_sleep(1); \
    if ((++_sp & 255u) == 0u) { if (xb_ld(&(bar)[XB_TMO])) break; if (_sp > XB_SPIN_CAP) { atomicAdd(&(bar)[XB_TMO], 1u); break; } } } } while (0)

struct XcdBarrier {
    unsigned* bar; unsigned x;
    volatile LAS unsigned* st;
};

__device__ __forceinline__ XcdBarrier xcd_barrier_post(unsigned* bar, volatile LAS unsigned* st) {
    XcdBarrier b; b.bar = bar; b.x = xb_xcc_id(); b.st = st;
    if (threadIdx.x == 0) (void)xb_add(&bar[XB_XCNT(b.x)], 1u);
    return b;
}
__device__ __forceinline__ void xcd_barrier_complete(unsigned* bar, unsigned x, unsigned& nloc, unsigned& nx) {
    const unsigned G = gridDim.x * gridDim.y * gridDim.z;
    unsigned sum, cnt, mine, sp = 0u;
    for (;;) {
        sum = 0u; cnt = 0u; mine = 0u;
#pragma unroll
        for (unsigned j = 0; j < 16; ++j) { const unsigned c = xb_ld(&bar[XB_XCNT(j)]); sum += c; cnt += (c > 0u) ? 1u : 0u; mine = (j == x) ? c : mine; }
        if (sum == G) break;
        __builtin_amdgcn_s_sleep(1);
        if ((++sp & 255u) == 0u) { if (xb_ld(&bar[XB_TMO])) break; if (sp > XB_SPIN_CAP) { atomicAdd(&bar[XB_TMO], 1u); break; } }
    }
    nloc = mine > 0u ? mine : 1u; nx = cnt > 0u ? cnt : 1u;
}

__device__ __forceinline__ void xcd_barrier(const XcdBarrier& b) {
    asm volatile("s_waitcnt vmcnt(0)" ::: "memory");
    __syncthreads();
    if (threadIdx.x == 0) {
        unsigned* bar = b.bar;
        __builtin_amdgcn_s_waitcnt(0);
        unsigned nloc = b.st[0], nx = b.st[1];
        if (nloc == 0u) { xcd_barrier_complete(bar, b.x, nloc, nx); b.st[0] = nloc; b.st[1] = nx; }
        const unsigned old = xb_add(&bar[XB_XSUB(b.x)], 1u);
        const unsigned gen = old / nloc;
        if (old + 1u == (gen + 1u) * nloc) {
            __builtin_amdgcn_fence(__ATOMIC_RELEASE, "agent");
            asm volatile("s_waitcnt vmcnt(0)" ::: "memory");
            const unsigned og = xb_add(&bar[XB_TOP], 1u);
            const unsigned tg = og / nx;
            if (og + 1u == (tg + 1u) * nx) xb_add(&bar[XB_TOPGEN], 1u);
            else XB_SPIN(xb_ld(&bar[XB_TOPGEN]) == tg, bar);
            __builtin_amdgcn_fence(__ATOMIC_ACQUIRE, "agent");
            xb_add(&bar[XB_XGEN(b.x)], 1u);
            asm volatile("s_waitcnt vmcnt(0)" ::: "memory");
        } else {
            XB_SPIN(xb_ld(&bar[XB_XGEN(b.x)]) == gen, bar);
            __builtin_amdgcn_fence(__ATOMIC_ACQUIRE, "agent");
            asm volatile("s_waitcnt vmcnt(0)" ::: "memory");
        }
    }
    __syncthreads();
}

__device__ __forceinline__ const Args* kargs() { auto p = __builtin_amdgcn_kernarg_segment_ptr(); asm volatile("" : "+s"(p)); return (const Args*)p; }
#define MK_COMMON() const Args* ka = kargs(); unsigned char* ws = ka->ws; const int G = gridDim.x, bid = blockIdx.x; LAS unsigned char* lds = (LAS unsigned char*)lds_raw; PG8_LAS float* P = (PG8_LAS float*)(lds + P_OFF); (void)P
extern __shared__ __attribute__((aligned(16))) unsigned char lds_raw[];
template <int Q> __device__ __forceinline__ void ph_ffn_in() { MK_COMMON();
    pg8::Gemm g{(const bf16*)(ws + WS_XB), (const bf16*)(ws + WS_WFI + Q * WFI_SZ), T, 2 * FF, D}; pg8::StaticOrder S; S.init(T, 2 * FF, G, bid);
    pg8::EpiSwiGLU E{(bf16*)(ws + WS_R), FF, (const float*)(ws + WS_SSQ), P + 1024}; pg8::gemm_phase<pg8::EpiSwiGLU, pg8::StaticOrder, true, true>(lds, g, S, E); }
template <int Q> __device__ __forceinline__ void ph_ffn_out() { MK_COMMON();
    pg8::Gemm g{(const bf16*)(ws + WS_R), (const bf16*)(ws + WS_WFO + Q * WFO_SZ), T, D, FF}; pg8::StaticOrder S; S.init(T, D, G, bid);
    pg8::EpiRes E{(bf16*)(ws + WS_XB), (float*)(ws + WS_SSQ), 0.5f, P}; pg8::gemm_phase<pg8::EpiRes, pg8::StaticOrder, true, true>(lds, g, S, E); }
__device__ __forceinline__ void ph_a_in() { MK_COMMON();
    pg8::Gemm g{(const bf16*)(ws + WS_XB), (const bf16*)(ws + WS_WAI), T, 2 * AD, D}; pg8::StaticOrder S; S.init(T, 2 * AD, G, bid);
    pg8::EpiAct<1> E{(bf16*)(ws + WS_R), (bf16*)(ws + WS_R + 128 * MiB), AD, AD / 256, (const float*)(ws + WS_SSQ), (float*)(ws + WS_SSQV), P, P + 1024}; pg8::gemm_phase<pg8::EpiAct<1>, pg8::StaticOrder, true, true>(lds, g, S, E); }
__device__ __forceinline__ void ph_sgu() { MK_COMMON();
    sgu_phase(lds, (bf16*)(ws + WS_R), (const bf16*)(ws + WS_R + 128 * MiB), (const float*)(ws + WS_SSQV), ka->in[6], ka->in[7], ka->in[8], G, bid); }
template <int MIX> __device__ __forceinline__ void ph_mix_out() { MK_COMMON();
    pg8::Gemm g{(const bf16*)(ws + WS_R + (MIX ? 64 * MiB : 0)), (const bf16*)(ws + (MIX ? WS_WBC : WS_WAO)), T, D, MIX ? D : AD}; pg8::StaticOrder S; S.init(T, D, G, bid);
    pg8::EpiRes E{(bf16*)(ws + WS_XB), (float*)(ws + WS_SSQ), 1.0f, P}; pg8::gemm_phase<pg8::EpiRes, pg8::StaticOrder, true, true>(lds, g, S, E); }
__device__ __forceinline__ void ph_b_in() { MK_COMMON();
    pg8::Gemm g{(const bf16*)(ws + WS_XB), (const bf16*)(ws + WS_WBI), T, D, D}; pg8::StaticOrder S; S.init(T, D, G, bid);
    pg8::EpiAct<0> E{(bf16*)(ws + WS_R), (bf16*)(ws + WS_R), D, 0, (const float*)(ws + WS_SSQ), nullptr, P, P + 1024}; pg8::gemm_phase<pg8::EpiAct<0>, pg8::StaticOrder, true, true>(lds, g, S, E); }
__device__ __forceinline__ void ph_pool() { MK_COMMON(); pool_phase((const bf16*)(ws + WS_R), (bf16*)(ws + WS_R + 64 * MiB), G, bid); }
__device__ __forceinline__ void ph_final() { MK_COMMON(); final_phase(ka->out, (const bf16*)(ws + WS_XB), (const float*)(ws + WS_SSQ), ka->in[14], G, bid); }
__device__ __forceinline__ void ph_pre() { MK_COMMON(); prepass(*ka, lds, G, bid); }

__device__ __forceinline__ void seam_barrier() {
    const Args* ka = kargs(); XcdBarrier b; b.bar = (unsigned*)(ka->ws + WS_CTL); b.x = xb_xcc_id(); b.st = (volatile LAS unsigned*)((LAS unsigned char*)lds_raw + MISC_OFF);
    xcd_barrier(b);
}
template <int LO, int HI> __global__ void __launch_bounds__(NT, 2) fwd_megakernel(Args args) {
    cg::grid_group grid = cg::this_grid();
    { volatile LAS unsigned* st = (volatile LAS unsigned*)((LAS unsigned char*)lds_raw + MISC_OFF); if (threadIdx.x < 64) st[threadIdx.x] = 0u;
      if (blockIdx.x == 0) { unsigned* bar = (unsigned*)(args.ws + WS_CTL); for (int i = threadIdx.x; i < XCD_BAR_WORDS; i += NT) __hip_atomic_store(bar + i, 0u, __ATOMIC_RELAXED, __HIP_MEMORY_SCOPE_AGENT);
          asm volatile("s_waitcnt vmcnt(0)" ::: "memory"); }
      __syncthreads(); }
#define PH(k, call) do { if constexpr (LO <= (k) && (k) < HI) { call; if constexpr ((k) + 1 < HI) { if constexpr ((k) == LO) { grid.sync(); const Args* ka = kargs(); unsigned* bar = (unsigned*)(ka->ws + WS_CTL); \
        if (threadIdx.x == 0) (void)xb_add(&bar[XB_XCNT(xb_xcc_id())], 1u); } else seam_barrier(); } } } while (0)
    PH(0, ph_pre());
    PH(1, ph_ffn_in<0>());  PH(2, ph_ffn_out<0>());
    PH(3, ph_a_in());       PH(4, ph_sgu());          PH(5, ph_mix_out<0>());
    PH(6, ph_ffn_in<1>());  PH(7, ph_ffn_out<1>());
    PH(8, ph_ffn_in<2>());  PH(9, ph_ffn_out<2>());
    PH(10, ph_b_in());      PH(11, ph_pool());        PH(12, ph_mix_out<1>());
    PH(13, ph_ffn_in<3>()); PH(14, ph_ffn_out<3>());
    PH(15, ph_final());
#undef PH
}
constexpr int N_PHASES = 16;
}

extern "C" void kernel_launch(void* const* d_in, const int* in_sizes, int n_in, void* d_out, int out_size, void* d_ws, size_t ws_size, hipStream_t stream) {
    static int grid = 0;
    if (grid == 0) {
        if (n_in != 15 || in_sizes[0] != mk::T * mk::D || out_size != mk::T * mk::D || ws_size < mk::WS_END) { fprintf(stderr, "kernel_launch: unexpected shapes (n_in %d, in0 %d, out %d, ws %zu)\n", n_in, n_in > 0 ? in_sizes[0] : -1, out_size, ws_size); grid = -1; return; }
        int dev = 0, cus = 0, per_cu = 0;
        if (hipGetDevice(&dev) != hipSuccess || hipDeviceGetAttribute(&cus, hipDeviceAttributeMultiprocessorCount, dev) != hipSuccess) { grid = -1; return; }
        if (hipFuncSetAttribute((const void*)mk::fwd_megakernel<0, mk::N_PHASES>, hipFuncAttributeMaxDynamicSharedMemorySize, mk::LDS_BYTES) != hipSuccess) { fprintf(stderr, "kernel_launch: hipFuncSetAttribute failed\n"); grid = -1; return; }
        if (hipOccupancyMaxActiveBlocksPerMultiprocessor(&per_cu, (const void*)mk::fwd_megakernel<0, mk::N_PHASES>, mk::NT, mk::LDS_BYTES) != hipSuccess || per_cu < 1) { fprintf(stderr, "kernel_launch: occupancy query says %d\n", per_cu); per_cu = 1; }
        (void)hipGetLastError();
        grid = cus;
    }
    if (grid < 0) return;
    mk::Args a{};
    for (int i = 0; i < 15; ++i) a.in[i] = (const float*)d_in[i];
    a.out = (float*)d_out; a.ws = (unsigned char*)d_ws;
    void* kargs[] = {&a};
    hipError_t e = hipLaunchCooperativeKernel((const void*)mk::fwd_megakernel<0, mk::N_PHASES>, dim3(grid), dim3(mk::NT), kargs, mk::LDS_BYTES, stream);
    if (e != hipSuccess) fprintf(stderr, "kernel_launch: cooperative launch failed: %s (grid %d)\n", hipGetErrorString(e), grid);
}
```
